# Optimizing an MI355X kernel written in HIP

```python
import jax, jax.numpy as jnp
from jax import lax
import numpy as np

D_MODEL = 1024
BATCH = 2
SEQ = 8192
DEPTH = 1

CHUNK = 64
PLE_DIM = 256
RW_HEADS = 8
RW_HEAD_DIM = 64
RW_WIDTH = RW_HEADS * RW_HEAD_DIM
RW_DECAY_LORA = 64
RW_ICLR_LORA = 64
RW_GATE_LORA = 128
RW_GN_EPS = 64e-5
GLA_HEADS = 4
GLA_KEY_DIM = 64
GLA_VAL_DIM = 128
GLA_QK_WIDTH = GLA_HEADS * GLA_KEY_DIM
GLA_V_WIDTH = GLA_HEADS * GLA_VAL_DIM
GLA_GATE_RANK = 16
GLA_GATE_TEMP = 16.0
MIX_WIDTH = RW_WIDTH + GLA_V_WIDTH
RW_COLS = 3 * RW_WIDTH + RW_DECAY_LORA + RW_ICLR_LORA + RW_GATE_LORA
GLA_COLS = 2 * GLA_QK_WIDTH + 2 * GLA_V_WIDTH + GLA_GATE_RANK
IN_COLS = RW_COLS + GLA_COLS
N_EXPERTS = 32
TOP_K = 4
D_FF = 1024
SWIGLU_ALPHA = 1.702
SWIGLU_LIMIT = 7.0
EXPERT_BLOCK = 256
NORM_EPS = 1e-6

kernel_name = "hybrid_rwkv7_gla_moe_ple_block"


def rmsnorm(x, g):
    xf = x.astype(jnp.float32)
    y = xf * lax.rsqrt(jnp.mean(xf * xf, axis=-1, keepdims=True) + NORM_EPS)
    return (y * g.astype(jnp.float32)).astype(x.dtype)


def token_shift(h, mu):
    prev = jnp.pad(h, ((0, 0), (1, 0), (0, 0)))[:, :-1]
    return h + (prev - h) * mu


def rwkv7_mix(h, w0, w2, a0, a2, g2, k_k, k_a, r_k, gn_w, gn_b):
    B, S, _ = h.shape
    H, D = RW_HEADS, RW_HEAD_DIM
    f32 = jnp.float32
    o0 = 0
    r = h[..., o0:o0 + RW_WIDTH]; o0 += RW_WIDTH
    k = h[..., o0:o0 + RW_WIDTH]; o0 += RW_WIDTH
    v = h[..., o0:o0 + RW_WIDTH]; o0 += RW_WIDTH
    dw = h[..., o0:o0 + RW_DECAY_LORA]; o0 += RW_DECAY_LORA
    da = h[..., o0:o0 + RW_ICLR_LORA]; o0 += RW_ICLR_LORA
    dg = h[..., o0:o0 + RW_GATE_LORA]

    w_log = -jax.nn.softplus(-(w0 + jnp.tanh(dw) @ w2)) - 0.5
    decay = jnp.exp(-jnp.exp(w_log.astype(f32)))
    iclr = jax.nn.sigmoid((a0 + da @ a2).astype(f32))
    gate = jax.nn.sigmoid(dg) @ g2

    kk = (k * k_k).astype(f32).reshape(B, S, H, D)
    kk = kk / jnp.maximum(jnp.sqrt(jnp.sum(kk * kk, -1, keepdims=True)), 1e-12)
    k = k.astype(f32) * (1.0 + (iclr - 1.0) * k_a.astype(f32))

    def heads(t):
        return t.astype(f32).reshape(B, S, H, D)

    r4, k4, v4, w4, a4 = heads(r), heads(k), heads(v), heads(decay), heads(iclr)

    def tm(t):
        return jnp.transpose(t, (1, 0, 2, 3))

    def step(state, inp):
        r_t, w_t, k_t, v_t, kk_t, a_t = inp
        sa = jnp.einsum('bhvk,bhk->bhv', state, -kk_t)
        state = (state * w_t[:, :, None, :]
                 + sa[..., None] * (kk_t * a_t)[:, :, None, :]
                 + v_t[..., None] * k_t[:, :, None, :])
        return state, jnp.einsum('bhvk,bhk->bhv', state, r_t)

    s0 = jnp.zeros((B, H, D, D), f32)
    _, o = lax.scan(step, s0, (tm(r4), tm(w4), tm(k4), tm(v4), tm(kk), tm(a4)))
    o = jnp.transpose(o, (1, 0, 2, 3))

    mu = jnp.mean(o, -1, keepdims=True)
    var = jnp.mean(jnp.square(o - mu), -1, keepdims=True)
    o = ((o - mu) * lax.rsqrt(var + RW_GN_EPS)).reshape(B, S, RW_WIDTH)
    o = o * gn_w.astype(f32) + gn_b.astype(f32)
    bonus = jnp.sum(r4 * k4 * r_k.astype(f32), -1, keepdims=True) * v4
    o = (o + bonus.reshape(B, S, RW_WIDTH)) * gate.astype(f32)
    return o.astype(h.dtype)


def gla_mix(h, gk2, gk_b, norm_g):
    B, S, _ = h.shape
    H, DK, DV = GLA_HEADS, GLA_KEY_DIM, GLA_VAL_DIM
    f32 = jnp.float32
    o0 = 0
    q = h[..., o0:o0 + GLA_QK_WIDTH]; o0 += GLA_QK_WIDTH
    k = h[..., o0:o0 + GLA_QK_WIDTH]; o0 += GLA_QK_WIDTH
    v = h[..., o0:o0 + GLA_V_WIDTH]; o0 += GLA_V_WIDTH
    g = h[..., o0:o0 + GLA_V_WIDTH]; o0 += GLA_V_WIDTH
    dgk = h[..., o0:o0 + GLA_GATE_RANK]

    log_a = jax.nn.log_sigmoid((dgk @ gk2 + gk_b).astype(f32)) / GLA_GATE_TEMP
    q = q.astype(f32) * (DK ** -0.5)
    NC = S // CHUNK

    def chunks(t, d):
        return t.astype(f32).reshape(B, NC, CHUNK, H, d).transpose(1, 0, 3, 2, 4)

    causal = jnp.tril(jnp.ones((CHUNK, CHUNK), bool))[:, :, None]

    def step(state, inp):
        qc, kc, vc, lac = inp
        b = jnp.cumsum(lac, axis=2)
        o_inter = jnp.einsum('bhcd,bhdv->bhcv', qc * jnp.exp(b), state)
        diff = b[:, :, :, None, :] - b[:, :, None, :, :]
        dec = jnp.exp(jnp.where(causal, diff, -jnp.inf))
        att = jnp.einsum('bhid,bhjd,bhijd->bhij', qc, kc, dec)
        o = o_inter + jnp.einsum('bhij,bhjv->bhiv', att, vc)
        b_last = b[:, :, -1:, :]
        state = (jnp.exp(b_last[:, :, 0, :])[..., None] * state
                 + jnp.einsum('bhjd,bhjv->bhdv', kc * jnp.exp(b_last - b), vc))
        return state, o

    s0 = jnp.zeros((B, H, DK, DV), f32)
    _, o = lax.scan(step, s0, (chunks(q, DK), chunks(k, DK), chunks(v, DV), chunks(log_a, DK)))
    o = o.transpose(1, 0, 3, 2, 4).reshape(B, S, H, DV)
    o = o * lax.rsqrt(jnp.mean(o * o, -1, keepdims=True) + NORM_EPS)
    o = o.reshape(B, S, GLA_V_WIDTH) * norm_g.astype(f32) * jax.nn.silu(g.astype(f32))
    return o.astype(h.dtype)


def moe(u, w_router, b_router, w1, b1, w2, b2):
    B, S, D = u.shape
    N = B * S
    A = N * TOP_K
    NB = (A + N_EXPERTS * (EXPERT_BLOCK - 1) + EXPERT_BLOCK - 1) // EXPERT_BLOCK
    xf = u.reshape(N, D)
    logits = (xf @ w_router + b_router).astype(jnp.float32)
    top_v, top_i = lax.top_k(logits, TOP_K)
    gates = jax.nn.softmax(top_v, axis=-1).astype(xf.dtype)

    flat_e = top_i.reshape(-1).astype(jnp.int32)
    flat_tok = jnp.arange(A, dtype=jnp.int32) // TOP_K
    flat_w = gates.reshape(-1)
    order = jnp.argsort(flat_e, stable=True)
    e_s, tok_s, w_s = flat_e[order], flat_tok[order], flat_w[order]

    counts = jax.ops.segment_sum(jnp.ones((A,), jnp.int32), flat_e, num_segments=N_EXPERTS)
    start = jnp.cumsum(counts) - counts
    pcounts = ((counts + EXPERT_BLOCK - 1) // EXPERT_BLOCK) * EXPERT_BLOCK
    pend = jnp.cumsum(pcounts)
    pstart = pend - pcounts
    dest = pstart[e_s] + (jnp.arange(A, dtype=jnp.int32) - start[e_s])

    tok_buf = jnp.zeros((NB * EXPERT_BLOCK,), jnp.int32).at[dest].set(tok_s)
    w_buf = jnp.zeros((NB * EXPERT_BLOCK,), xf.dtype).at[dest].set(w_s)
    block_rows = jnp.arange(NB, dtype=jnp.int32) * EXPERT_BLOCK
    block_e = jnp.clip(jnp.searchsorted(pend, block_rows, side='right'), 0, N_EXPERTS - 1)

    def expert_block(args):
        tok_b, w_b, e = args
        xb = xf[tok_b]
        hgl = xb @ w1[e] + b1[e]
        x_glu = jnp.minimum(hgl[:, :D_FF], SWIGLU_LIMIT)
        x_lin = jnp.clip(hgl[:, D_FF:], -SWIGLU_LIMIT, SWIGLU_LIMIT)
        act = (x_lin + 1.0) * (x_glu * jax.nn.sigmoid(SWIGLU_ALPHA * x_glu))
        return (act @ w2[e] + b2[e]) * w_b[:, None]

    ys = lax.map(expert_block, (tok_buf.reshape(NB, EXPERT_BLOCK),
                                w_buf.reshape(NB, EXPERT_BLOCK), block_e))
    out = jnp.zeros_like(xf).at[tok_buf].add(ys.reshape(-1, D))
    return out.reshape(B, S, D)


def setup_inputs(seed: int = 0) -> dict:
    key = jax.random.key(seed)
    ks = jax.random.split(key, 40)
    f32 = jnp.float32

    def nrm(k, shape, scale):
        return jax.random.normal(k, shape, f32) * scale

    def gain(k, shape):
        return 1.0 + 0.05 * jax.random.normal(k, shape, f32)

    L, D, E, F = DEPTH, D_MODEL, N_EXPERTS, D_FF
    return {
        "x": nrm(ks[0], (BATCH, SEQ, D), 1.0),
        "p": nrm(ks[1], (L, BATCH, SEQ, PLE_DIM), 1.0),
        "norm_mix": gain(ks[2], (L, D)),
        "w_in": nrm(ks[3], (L, D, IN_COLS), D ** -0.5),
        "shift_mu": jax.random.uniform(ks[4], (L, RW_COLS), f32),
        "rw_w0": jax.random.uniform(ks[5], (L, RW_WIDTH), f32, -6.0, -1.0),
        "rw_w2": nrm(ks[6], (L, RW_DECAY_LORA, RW_WIDTH), 0.1),
        "rw_a0": nrm(ks[7], (L, RW_WIDTH), 0.5),
        "rw_a2": nrm(ks[8], (L, RW_ICLR_LORA, RW_WIDTH), 0.5 * RW_ICLR_LORA ** -0.5),
        "rw_g2": nrm(ks[9], (L, RW_GATE_LORA, RW_WIDTH), RW_GATE_LORA ** -0.5),
        "rw_kk": 0.85 + 0.05 * jax.random.normal(ks[10], (L, RW_WIDTH), f32),
        "rw_ka": gain(ks[11], (L, RW_WIDTH)),
        "rw_rk": nrm(ks[12], (L, RW_HEADS, RW_HEAD_DIM), 0.1),
        "rw_gn_w": gain(ks[13], (L, RW_WIDTH)),
        "rw_gn_b": nrm(ks[14], (L, RW_WIDTH), 0.01),
        "gla_gk2": nrm(ks[15], (L, GLA_GATE_RANK, GLA_QK_WIDTH), GLA_GATE_RANK ** -0.5),
        "gla_gk_b": nrm(ks[16], (L, GLA_QK_WIDTH), 0.1),
        "gla_norm": gain(ks[17], (L, GLA_V_WIDTH)),
        "w_out": nrm(ks[18], (L, MIX_WIDTH, D), MIX_WIDTH ** -0.5),
        "norm_ffn": gain(ks[19], (L, D)),
        "w_router": nrm(ks[20], (L, D, E), D ** -0.5),
        "b_router": nrm(ks[21], (L, E), 0.01),
        "w1": nrm(ks[22], (L, E, D, 2 * F), D ** -0.5),
        "b1": nrm(ks[23], (L, E, 2 * F), 0.01),
        "w2": nrm(ks[24], (L, E, F, D), F ** -0.5),
        "b2": nrm(ks[25], (L, E, D), 0.01),
        "norm_ple": gain(ks[26], (L, D)),
        "w_ple_gate": nrm(ks[27], (L, D, D), D ** -0.5),
        "w_ple": nrm(ks[28], (L, PLE_DIM, D), PLE_DIM ** -0.5),
        "norm_final": gain(ks[29], (D,)),
    }


def reference(x, p, norm_mix, w_in, shift_mu, rw_w0, rw_w2, rw_a0, rw_a2, rw_g2,
              rw_kk, rw_ka, rw_rk, rw_gn_w, rw_gn_b, gla_gk2, gla_gk_b, gla_norm,
              w_out, norm_ffn, w_router, b_router, w1, b1, w2, b2,
              norm_ple, w_ple_gate, w_ple, norm_final):
    h = x
    for i in range(DEPTH):
        u = rmsnorm(h, norm_mix[i])
        proj = u @ w_in[i]
        rw_in = token_shift(proj[..., :RW_COLS], shift_mu[i])
        y_rw = rwkv7_mix(rw_in, rw_w0[i], rw_w2[i], rw_a0[i], rw_a2[i], rw_g2[i],
                         rw_kk[i], rw_ka[i], rw_rk[i], rw_gn_w[i], rw_gn_b[i])
        y_gla = gla_mix(proj[..., RW_COLS:], gla_gk2[i], gla_gk_b[i], gla_norm[i])
        h = h + jnp.concatenate([y_rw, y_gla], axis=-1) @ w_out[i]
        u = rmsnorm(h, norm_ffn[i])
        h = h + moe(u, w_router[i], b_router[i], w1[i], b1[i], w2[i], b2[i])
        u = rmsnorm(h, norm_ple[i])
        h = h + jax.nn.sigmoid(u @ w_ple_gate[i]) * (p[i] @ w_ple[i])
    return rmsnorm(h, norm_final)
```

```cpp
#define PROBE_DUP -1
#include <hip/hip_runtime.h>
#include <cstdio>
#include <cstdint>

#define LAS __attribute__((address_space(3)))
typedef unsigned short bf16;
typedef short bf16x8 __attribute__((ext_vector_type(8)));
typedef float f32x4 __attribute__((ext_vector_type(4)));
typedef float f32x2 __attribute__((ext_vector_type(2)));
typedef unsigned u32x4 __attribute__((ext_vector_type(4)));
typedef unsigned u32x2 __attribute__((ext_vector_type(2)));

namespace pg8 {
constexpr int BM = 256, BK = 64, HALF = 128, HTB = HALF * BK * 2, STAGE_BYTES = 8 * HTB, NXCD = 8, WGM = 8;
__host__ __device__ __forceinline__ int lds_byte(int r, int c) { const int st = (r >> 4) * 2 + (c >> 5), rr = r & 15, cc = c & 31, ob = rr * 64 + cc * 2; return st * 1024 + (ob ^ (((ob >> 9) & 1) << 5)); }
__host__ __device__ __forceinline__ void stage_rc(int b, int& R, int& C) { const int st = b / 1024, sb = b % 1024, swz = sb ^ (((sb >> 9) & 1) << 5); R = (st >> 1) * 16 + swz / 64; C = (st & 1) * 32 + (swz % 64) / 2; }
__host__ __device__ __forceinline__ int perm32(int rho) { const int n = rho >> 4, i = rho & 15; return 8 * (i >> 2) + 4 * n + (i & 3); }

struct Unit { int pm, pn, e, aux; };
struct Gemm { const bf16* A; const bf16* Bt; int M, N, K; };

struct StaticOrder {
    int nM, nN, nwg, G, c;
    __host__ __device__ void init(int M, int N, int G_, int c_) { nM = M / BM; nN = N / BM; nwg = nM * nN; G = G_; c = c_; }
    __host__ __device__ bool next(int i, Unit& u) const {
        const long L = (long)i * G + c; if (L >= nwg) return false;
        int wgid = (int)L; { const int q = nwg / NXCD, r = nwg % NXCD, xcd = wgid % NXCD, off = wgid / NXCD; wgid = (xcd < r ? xcd * (q + 1) : r * (q + 1) + (xcd - r) * q) + off; }
        const int nig = WGM * nN, gid = wgid / nig, fm = gid * WGM, gsz = (nM - fm) < WGM ? (nM - fm) : WGM;
        u.pm = fm + ((wgid % nig) % gsz); u.pn = (wgid % nig) / gsz; u.e = 0; u.aux = 0; return true;
    }
    __device__ __forceinline__ const LAS int* rowtab(int) const { return nullptr; }
};

typedef __bf16 bf16x2_t __attribute__((ext_vector_type(2)));
__device__ __forceinline__ unsigned cvt_pk_bf16(float lo, float hi) { const f32x2 v = {lo, hi}; const bf16x2_t r = __builtin_convertvector(v, bf16x2_t); return __builtin_bit_cast(unsigned, r); }


template <class Epi, class Sched, bool GATHER, bool ALIGN_EPI, bool SP2>
__device__ __forceinline__ void gemm_phase(LAS unsigned char* lds, const Gemm g, const Sched& S, const Epi& E) {
    const int tid = threadIdx.x, wid = __builtin_amdgcn_readfirstlane(tid >> 6), lane = tid & 63, wr = wid >> 2, wc = wid & 3, fr = lane & 15, fq = lane >> 4;
    const int K = g.K, nt = K / BK;
    unsigned voffA[2], voffB[2]; int stR[2], stC[2];
#pragma unroll
    for (int i = 0; i < 2; ++i) { int R, C; stage_rc(tid * 16 + i * 8192, R, C); const int Rb = Epi::PERM ? ((R & ~31) + perm32(R & 31)) : R;
        voffA[i] = (unsigned)(R * K + C) * 2u; voffB[i] = (unsigned)(Rb * K + C) * 2u; stR[i] = R; stC[i] = C; }
    unsigned gvc[2][2], gvn[2][2];
    const size_t kstep = (size_t)(BK * 2);
    const size_t hstep = (size_t)HALF * K * 2;
    const size_t tstep = 2 * hstep;
    const unsigned ldsw = (unsigned)wid * 1024u;
    const int aoff = lds_byte(wr * 64 + fr, fq * 8), boff = lds_byte(wc * 32 + fr, fq * 8);
#define PG8_SA(b, h) (((b) * 2 + (h)) * HTB)
#define PG8_SB(b, h) ((4 + (b) * 2 + (h)) * HTB)
#define PG8_STAGE(bufoff, gbase, voff) do { _Pragma("unroll") for (int _i = 0; _i < 2; ++_i) \
        __builtin_amdgcn_global_load_lds((const unsigned*)((const char*)(gbase) + (voff)[_i]), (LAS unsigned*)(lds + (bufoff) + ldsw + _i * 8192), 16, 0, 0); } while (0)
#define PG8_STAGE_A(bufoff, p, h, nx) do { if constexpr (GATHER) { unsigned _v[2]; _v[0] = (nx) ? gvn[h][0] : gvc[h][0]; _v[1] = (nx) ? gvn[h][1] : gvc[h][1]; PG8_STAGE(bufoff, p, _v); } \
        else { PG8_STAGE(bufoff, (p) + (h) * hstep, voffA); } } while (0)
#define PG8_LDA(dst, b, h) do { _Pragma("unroll") for (int m = 0; m < 4; ++m) _Pragma("unroll") for (int k = 0; k < 2; ++k) dst[m][k] = *(const LAS bf16x8*)(lds + PG8_SA(b, h) + aoff + m * 2048 + k * 1024); } while (0)
#define PG8_LDB(dst, b, h) do { _Pragma("unroll") for (int n = 0; n < 2; ++n) _Pragma("unroll") for (int k = 0; k < 2; ++k) dst[n][k] = *(const LAS bf16x8*)(lds + PG8_SB(b, h) + boff + n * 2048 + k * 1024); } while (0)
#define PG8_MMA(ai, bj, At, Bt) do { __builtin_amdgcn_s_setprio(1); _Pragma("unroll") for (int m = 0; m < 4; ++m) _Pragma("unroll") for (int n = 0; n < 2; ++n) _Pragma("unroll") for (int k = 0; k < 2; ++k) \
        acc[ai][bj][m][n] = __builtin_amdgcn_mfma_f32_16x16x32_bf16(Bt[n][k], At[m][k], acc[ai][bj][m][n], 0, 0, 0); __builtin_amdgcn_s_setprio(0); } while (0)
#define PG8_WAIT_V(n) asm volatile("s_waitcnt vmcnt(" #n ")" ::: "memory")
#define PG8_WAIT_L(n) asm volatile("s_waitcnt lgkmcnt(" #n ")" ::: "memory")
#define PG8_BAR __builtin_amdgcn_s_barrier()
#define PG8_SCHED __builtin_amdgcn_sched_barrier(0)
#define PG8_GV(dst, tab) do { _Pragma("unroll") for (int _h = 0; _h < 2; ++_h) _Pragma("unroll") for (int _i = 0; _i < 2; ++_i) \
        dst[_h][_i] = (unsigned)((tab)[_h * HALF + stR[_i]] * K + stC[_i]) * 2u; } while (0)
    Unit cur, nxt; int ui = 0;
    if (!S.next(0, cur)) return;
    f32x4 acc[2][2][4][2];
#pragma unroll
    for (int a = 0; a < 2; ++a)
#pragma unroll
        for (int b = 0; b < 2; ++b)
#pragma unroll
            for (int m = 0; m < 4; ++m)
#pragma unroll
                for (int n = 0; n < 2; ++n) acc[a][b][m][n] = (f32x4){0.f, 0.f, 0.f, 0.f};
    bf16x8 At[4][2], B0[2][2], B1[2][2];
    const char* cA = GATHER ? (const char*)g.A : (const char*)g.A + (size_t)cur.pm * tstep; const char* cB = (const char*)g.Bt + (size_t)cur.pn * tstep;
    if constexpr (GATHER) { const LAS int* tab = S.rowtab(0); PG8_GV(gvc, tab);
#pragma unroll
        for (int h = 0; h < 2; ++h) { gvn[h][0] = gvc[h][0]; gvn[h][1] = gvc[h][1]; } }
    if constexpr (SP2) {
        PG8_STAGE(PG8_SB(0, 0), cB, voffB); PG8_STAGE(PG8_SB(0, 1), cB + hstep, voffB); PG8_STAGE_A(PG8_SA(0, 0), cA, 0, false); PG8_STAGE_A(PG8_SA(0, 1), cA, 1, false);
        if (wr == 1) PG8_BAR;
        PG8_WAIT_V(2); PG8_BAR;
        PG8_STAGE(PG8_SB(1, 0), cB + kstep, voffB); PG8_STAGE_A(PG8_SA(1, 0), cA + kstep, 0, false); PG8_STAGE(PG8_SB(1, 1), cB + hstep + kstep, voffB);
        PG8_WAIT_V(6); PG8_BAR;
    } else {
        PG8_STAGE(PG8_SB(0, 0), cB, voffB); PG8_STAGE_A(PG8_SA(0, 0), cA, 0, false); PG8_STAGE(PG8_SB(0, 1), cB + hstep, voffB); PG8_STAGE_A(PG8_SA(0, 1), cA, 1, false);
        if (wr == 1) PG8_BAR;
        PG8_WAIT_V(4); PG8_BAR;
        PG8_STAGE(PG8_SB(1, 0), cB + kstep, voffB); PG8_STAGE_A(PG8_SA(1, 0), cA + kstep, 0, false); PG8_STAGE(PG8_SB(1, 1), cB + hstep + kstep, voffB);
        PG8_WAIT_V(6); PG8_BAR;
    }
    for (;;) {
        const bool has_next = S.next(ui + 1, nxt);
        if constexpr (GATHER) { if (has_next) { const LAS int* tab = S.rowtab(ui + 1); PG8_GV(gvn, tab); } }
        const char* nA = GATHER ? (const char*)g.A : (has_next ? (const char*)g.A + (size_t)nxt.pm * tstep : cA); const char* nB = has_next ? (const char*)g.Bt + (size_t)nxt.pn * tstep : cB;
        for (int t = 0; t < nt; t += 2) {
            const bool last = (t == nt - 2);
            const bool nx = last && has_next;
            const char* a1 = cA + (size_t)(t + 1) * kstep;
            const char* a2 = last ? nA : cA + (size_t)(t + 2) * kstep; const char* b2 = last ? nB : cB + (size_t)(t + 2) * kstep;
            const char* a3 = a2 + kstep; const char* b3 = b2 + kstep;
            if constexpr (SP2) {
            PG8_LDB(B0, 0, 0); PG8_LDB(B1, 0, 1); PG8_SCHED; PG8_LDA(At, 0, 0); PG8_STAGE_A(PG8_SA(1, 1), a1, 1, false);
            PG8_WAIT_V(8); PG8_WAIT_L(0); PG8_BAR; PG8_MMA(0, 0, At, B0); PG8_MMA(0, 1, At, B1); PG8_BAR; PG8_SCHED;
            PG8_LDA(At, 0, 1); PG8_STAGE(PG8_SB(0, 0), b2, voffB); PG8_STAGE(PG8_SB(0, 1), b2 + hstep, voffB); PG8_STAGE_A(PG8_SA(0, 0), a2, 0, nx);
            PG8_WAIT_V(8); PG8_WAIT_L(0); PG8_BAR; PG8_MMA(1, 0, At, B0); PG8_MMA(1, 1, At, B1); PG8_BAR; PG8_SCHED;
            PG8_LDB(B0, 1, 0); PG8_LDB(B1, 1, 1); PG8_SCHED; PG8_LDA(At, 1, 0); PG8_STAGE_A(PG8_SA(0, 1), a2, 1, nx);
            PG8_WAIT_V(8); PG8_WAIT_L(0); PG8_BAR; PG8_MMA(0, 0, At, B0); PG8_MMA(0, 1, At, B1); PG8_BAR; PG8_SCHED;
            PG8_LDA(At, 1, 1); PG8_STAGE(PG8_SB(1, 0), b3, voffB); PG8_STAGE(PG8_SB(1, 1), b3 + hstep, voffB); PG8_STAGE_A(PG8_SA(1, 0), a3, 0, nx);
            PG8_WAIT_V(8); PG8_WAIT_L(0); PG8_BAR; PG8_MMA(1, 0, At, B0); PG8_MMA(1, 1, At, B1); PG8_BAR; PG8_SCHED;
            } else {
            PG8_LDB(B0, 0, 0); PG8_SCHED; PG8_LDA(At, 0, 0); PG8_STAGE_A(PG8_SA(1, 1), a1, 1, false);
            PG8_WAIT_L(8); PG8_BAR; PG8_WAIT_L(0); PG8_MMA(0, 0, At, B0); PG8_BAR; PG8_SCHED;
            PG8_LDB(B1, 0, 1); PG8_STAGE(PG8_SB(0, 0), b2, voffB);
            PG8_BAR; PG8_WAIT_L(0); PG8_MMA(0, 1, At, B1); PG8_BAR;
            PG8_LDA(At, 0, 1); PG8_STAGE_A(PG8_SA(0, 0), a2, 0, nx);
            PG8_BAR; PG8_WAIT_L(0); PG8_MMA(1, 0, At, B0); PG8_BAR; PG8_SCHED;
            PG8_STAGE(PG8_SB(0, 1), b2 + hstep, voffB);
            PG8_WAIT_V(6); PG8_BAR; PG8_MMA(1, 1, At, B1); PG8_BAR;
            PG8_LDB(B0, 1, 0); PG8_SCHED; PG8_LDA(At, 1, 0); PG8_STAGE_A(PG8_SA(0, 1), a2, 1, nx);
            PG8_WAIT_L(8); PG8_BAR; PG8_WAIT_L(0); PG8_MMA(0, 0, At, B0); PG8_BAR; PG8_SCHED;
            PG8_LDB(B1, 1, 1); PG8_STAGE(PG8_SB(1, 0), b3, voffB);
            PG8_BAR; PG8_WAIT_L(0); PG8_MMA(0, 1, At, B1); PG8_BAR;
            PG8_LDA(At, 1, 1); PG8_STAGE_A(PG8_SA(1, 0), a3, 0, nx);
            PG8_BAR; PG8_WAIT_L(0); PG8_MMA(1, 0, At, B0); PG8_BAR; PG8_SCHED;
            PG8_STAGE(PG8_SB(1, 1), b3 + hstep, voffB);
            PG8_WAIT_V(6); PG8_BAR; PG8_MMA(1, 1, At, B1); PG8_BAR;
            }
        }
        if constexpr (ALIGN_EPI) { if (wr == 0) PG8_BAR; }
        E(acc, cur, wr, wc, fr, fq);
        if (!has_next) break;
#pragma unroll
        for (int a = 0; a < 2; ++a)
#pragma unroll
            for (int b = 0; b < 2; ++b)
#pragma unroll
                for (int m = 0; m < 4; ++m)
#pragma unroll
                    for (int n = 0; n < 2; ++n) acc[a][b][m][n] = (f32x4){0.f, 0.f, 0.f, 0.f};
        cur = nxt; cA = nA; cB = nB; ++ui;
        if constexpr (GATHER) {
#pragma unroll
            for (int h = 0; h < 2; ++h) { gvc[h][0] = gvn[h][0]; gvc[h][1] = gvn[h][1]; } }
        if constexpr (ALIGN_EPI) { if (wr == 1) PG8_BAR; }
    }
    PG8_WAIT_V(0);
    if constexpr (!ALIGN_EPI) { if (wr == 0) PG8_BAR; }
    PG8_BAR;
#undef PG8_SA
#undef PG8_SB
#undef PG8_STAGE
#undef PG8_STAGE_A
#undef PG8_LDA
#undef PG8_LDB
#undef PG8_MMA
#undef PG8_WAIT_V
#undef PG8_WAIT_L
#undef PG8_BAR
#undef PG8_SCHED
#undef PG8_GV
}
}
constexpr int NTOK = 16384, DM = 1024, SEQ = 8192, NB = 2;
constexpr int NPROJ = 3584;
constexpr int IN_COLS = 3344;
constexpr int C_RR = 0, C_RK = 512, C_RV = 1024, C_DW = 1536, C_DA = 1600, C_DG = 1664;
constexpr int C_GQ = 1792, C_GK = 2048, C_GV = 2304, C_GG = 2816, C_GD = 3328;
constexpr int NEXP = 32, DFF = 1024, ECAP = 16384;
constexpr int NCH = 128;
constexpr int RW_UNITS = NB * 8 * NCH;
constexpr int GL_UNITS = NB * 4 * NCH;
constexpr int NWAVES = 8;
constexpr float NORM_EPS = 1e-6f, GN_EPS = 64e-5f;

constexpr size_t MiB = 1u << 20;
constexpr size_t WS_CTL = 0, CTL_ZERO_BYTES = 1 * MiB;
constexpr size_t WS_WINT = 2 * MiB;
constexpr size_t WS_WOUTT = 10 * MiB, WS_WGT = 12 * MiB, WS_WPT = 14 * MiB;
constexpr size_t WS_LW2T = 15 * MiB, WS_LA2T = WS_LW2T + 65536, WS_LG2T = WS_LA2T + 65536;
constexpr size_t WS_WRH = WS_LG2T + 131072, WS_WRL = WS_WRH + 65536;
constexpr size_t WS_W1T = 16 * MiB;
constexpr size_t WS_W2T = 144 * MiB;
constexpr size_t WS_U = 208 * MiB;
constexpr size_t WS_PB = 240 * MiB;
constexpr size_t WS_PP = 248 * MiB;
constexpr size_t WS_PROJ = 280 * MiB;
constexpr size_t WS_GATEB = 392 * MiB, WS_BONUSB = 408 * MiB;
constexpr size_t WS_PLT = 424 * MiB;
constexpr size_t WS_DV = 440 * MiB;
constexpr size_t WS_QT = 441 * MiB;
constexpr size_t WS_GB = 473 * MiB;
constexpr size_t WS_OL = 489 * MiB;
constexpr size_t WS_S0 = 521 * MiB;
constexpr size_t WS_LS = 537 * MiB;
constexpr size_t WS_GDEC = 569 * MiB;
constexpr size_t WS_SG = 570 * MiB;
constexpr size_t WS_YMIX = 586 * MiB;
constexpr size_t WS_H1 = 618 * MiB;
constexpr size_t WS_RT = 682 * MiB;
constexpr size_t WS_GW = 684 * MiB;
constexpr size_t WS_ACT = 280 * MiB;
constexpr size_t WS_YB = 424 * MiB;
constexpr size_t WS_END = 686 * MiB;
constexpr int CW_BAR = 4096;
constexpr int CW_CNT = 8192;

constexpr int RING_BYTES = 131072;
constexpr int LDS_BYTES = 160 * 1024;
constexpr int MISC_OFF = LDS_BYTES - 64;
constexpr int MOE_TAB_OFF = RING_BYTES;
constexpr int MOE_ROWTAB_OFF = RING_BYTES + 512;
constexpr int MAXU = 16;
static_assert(MOE_ROWTAB_OFF + MAXU * 1024 <= MISC_OFF, "LDS map");

#define RLX_AGENT __ATOMIC_RELAXED, __HIP_MEMORY_SCOPE_AGENT
#define LDS_WAIT() asm volatile("s_waitcnt lgkmcnt(0)" ::: "memory")
#define VM_WAIT() asm volatile("s_waitcnt vmcnt(0)" ::: "memory")

__device__ __forceinline__ float bf2f(unsigned v) { return __uint_as_float(v << 16); }
__device__ __forceinline__ unsigned f2bf(float f) { unsigned u = __float_as_uint(f); return (u + 0x7fffu + ((u >> 16) & 1u)) >> 16; }
__device__ __forceinline__ unsigned pk2(float lo, float hi) { return pg8::cvt_pk_bf16(lo, hi); }
__device__ __forceinline__ float bflo(unsigned w) { return __uint_as_float(w << 16); }
__device__ __forceinline__ float bfhi(unsigned w) { return __uint_as_float(w & 0xffff0000u); }
template <int CTRL> __device__ __forceinline__ float dppx(float v) { return __int_as_float(__builtin_amdgcn_update_dpp(0, __float_as_int(v), CTRL, 0xf, 0xf, true)); }
__device__ __forceinline__ float rdlane(float v, int l) { return __int_as_float(__builtin_amdgcn_readlane(__float_as_int(v), l)); }
__device__ __forceinline__ float wave_sum(float v) {
    v += dppx<0xB1>(v); v += dppx<0x4E>(v); v += dppx<0x141>(v); v += dppx<0x140>(v);
    return (rdlane(v, 0) + rdlane(v, 16)) + (rdlane(v, 32) + rdlane(v, 48));
}
__device__ __forceinline__ float sigmoidf_(float x) { return 1.0f / (1.0f + __expf(-x)); }

#define XB_TMO      128
#define XB_XCNT(j)  (256  + 64 * (j))
#define XB_XSUB(j)  (1280 + 64 * (j))
#define XB_XGEN(j)  (2304 + 64 * (j))
#define XB_TOP      3328
#define XB_TOPGEN   3392
#define XCD_BAR_WORDS 3456
#define XB_SPIN_CAP (1u << 22)
__device__ __forceinline__ unsigned xb_ld(unsigned* p)              { return __hip_atomic_load(p, __ATOMIC_RELAXED, __HIP_MEMORY_SCOPE_AGENT); }
__device__ __forceinline__ unsigned xb_add(unsigned* p, unsigned v) { return __hip_atomic_fetch_add(p, v, __ATOMIC_RELAXED, __HIP_MEMORY_SCOPE_AGENT); }
__device__ __forceinline__ unsigned xb_xcc_id() { return (unsigned)__builtin_amdgcn_s_getreg((3 << 11) | 20) & 0xFu; }
#define XB_SPIN(cond, bar) do { unsigned _sp = 0; while (cond) { __builtin_amdgcn_s_sleep(1); \
    if ((++_sp & 255u) == 0u) { if (xb_ld(&(bar)[XB_TMO])) break; if (_sp > XB_SPIN_CAP) { atomicAdd(&(bar)[XB_TMO], 1u); break; } } } } while (0)
struct XcdBarrier { unsigned* bar; unsigned x; volatile LAS unsigned* st; };
__device__ __forceinline__ XcdBarrier xcd_barrier_post(unsigned* bar, volatile LAS unsigned* st) {
    XcdBarrier b; b.bar = bar; b.x = xb_xcc_id(); b.st = st;
    if (threadIdx.x == 0) (void)xb_add(&bar[XB_XCNT(b.x)], 1u);
    return b;
}
__device__ __forceinline__ void xcd_barrier_complete(unsigned* bar, unsigned x, unsigned& nloc, unsigned& nx) {
    const unsigned G = gridDim.x * gridDim.y * gridDim.z;
    unsigned sum, cnt, mine, sp = 0u;
    for (;;) {
        sum = 0u; cnt = 0u; mine = 0u;
#pragma unroll
        for (unsigned j = 0; j < 16; ++j) { const unsigned c = xb_ld(&bar[XB_XCNT(j)]); sum += c; cnt += (c > 0u) ? 1u : 0u; mine = (j == x) ? c : mine; }
        if (sum == G) break;
        __builtin_amdgcn_s_sleep(1);
        if ((++sp & 255u) == 0u) { if (xb_ld(&bar[XB_TMO])) break; if (sp > XB_SPIN_CAP) { atomicAdd(&bar[XB_TMO], 1u); break; } }
    }
    nloc = mine > 0u ? mine : 1u; nx = cnt > 0u ? cnt : 1u;
}
__device__ __forceinline__ void xcd_barrier(const XcdBarrier& b) {
    asm volatile("s_waitcnt vmcnt(0)" ::: "memory");
    __syncthreads();
    if (threadIdx.x == 0) {
        unsigned* bar = b.bar;
        __builtin_amdgcn_s_waitcnt(0);
        unsigned nloc = b.st[0], nx = b.st[1];
        if (nloc == 0u) { xcd_barrier_complete(bar, b.x, nloc, nx); b.st[0] = nloc; b.st[1] = nx; }
        const unsigned old = xb_add(&bar[XB_XSUB(b.x)], 1u);
        const unsigned gen = old / nloc;
        if (old + 1u == (gen + 1u) * nloc) {
            __builtin_amdgcn_fence(__ATOMIC_RELEASE, "agent");
            asm volatile("s_waitcnt vmcnt(0)" ::: "memory");
            const unsigned og = xb_add(&bar[XB_TOP], 1u);
            const unsigned tg = og / nx;
            if (og + 1u == (tg + 1u) * nx) xb_add(&bar[XB_TOPGEN], 1u);
            else XB_SPIN(xb_ld(&bar[XB_TOPGEN]) == tg, bar);
            __builtin_amdgcn_fence(__ATOMIC_ACQUIRE, "agent");
            xb_add(&bar[XB_XGEN(b.x)], 1u);
            asm volatile("s_waitcnt vmcnt(0)" ::: "memory");
        } else {
            XB_SPIN(xb_ld(&bar[XB_XGEN(b.x)]) == gen, bar);
            __builtin_amdgcn_fence(__ATOMIC_ACQUIRE, "agent");
            asm volatile("s_waitcnt vmcnt(0)" ::: "memory");
        }
    }
    __syncthreads();
}

using pg8::Unit; using pg8::HALF; using pg8::BM;
struct EpiBf16 {
    static constexpr bool PERM = true;
    bf16* O; int ldc;
    __device__ __forceinline__ void operator()(const f32x4 (&acc)[2][2][4][2], const Unit& u, int wr, int wc, int fr, int fq) const {
        const int row0 = u.pm * BM + wr * 64 + fr, col0 = u.pn * BM + wc * 32 + 8 * fq;
#pragma unroll
        for (int ai = 0; ai < 2; ++ai)
#pragma unroll
            for (int m = 0; m < 4; ++m) { bf16* rowp = O + (size_t)(row0 + ai * HALF + m * 16) * ldc + col0;
#pragma unroll
                for (int bj = 0; bj < 2; ++bj) { const f32x4 v0 = acc[ai][bj][m][0], v1 = acc[ai][bj][m][1];
                    u32x4 w; w.x = pk2(v0[0], v0[1]); w.y = pk2(v0[2], v0[3]); w.z = pk2(v1[0], v1[1]); w.w = pk2(v1[2], v1[3]);
                    *(u32x4*)(rowp + bj * HALF) = w; } }
    }
};
struct EpiResF32 {
    static constexpr bool PERM = false;
    const float* R; float* C;
    __device__ __forceinline__ void operator()(const f32x4 (&acc)[2][2][4][2], const Unit& u, int wr, int wc, int fr, int fq) const {
        const int row0 = u.pm * BM + wr * 64 + fr, col0 = u.pn * BM + wc * 32 + 4 * fq;
#pragma unroll
        for (int ai = 0; ai < 2; ++ai)
#pragma unroll
            for (int m = 0; m < 4; ++m) { const size_t off = (size_t)(row0 + ai * HALF + m * 16) * DM + col0;
#pragma unroll
                for (int bj = 0; bj < 2; ++bj)
#pragma unroll
                    for (int n = 0; n < 2; ++n) { const f32x4 r = *(const f32x4*)(R + off + bj * HALF + n * 16); *(f32x4*)(C + off + bj * HALF + n * 16) = r + acc[ai][bj][m][n]; }
                asm volatile("" ::: "memory"); }
    }
};
struct EpiGate {
    static constexpr bool PERM = false;
    const float* H; const bf16* PP; float* C;
    __device__ __forceinline__ void operator()(const f32x4 (&acc)[2][2][4][2], const Unit& u, int wr, int wc, int fr, int fq) const {
        const int row0 = u.pm * BM + wr * 64 + fr, col0 = u.pn * BM + wc * 32 + 4 * fq;
#pragma unroll
        for (int ai = 0; ai < 2; ++ai)
#pragma unroll
            for (int m = 0; m < 4; ++m) { const size_t off = (size_t)(row0 + ai * HALF + m * 16) * DM + col0;
#pragma unroll
                for (int bj = 0; bj < 2; ++bj)
#pragma unroll
                    for (int n = 0; n < 2; ++n) { const size_t o = off + bj * HALF + n * 16; const f32x4 h = *(const f32x4*)(H + o); const u32x2 pw = *(const u32x2*)(PP + o); const f32x4 a = acc[ai][bj][m][n];
                        f32x4 r; r[0] = h[0] + sigmoidf_(a[0]) * bflo(pw.x); r[1] = h[1] + sigmoidf_(a[1]) * bfhi(pw.x); r[2] = h[2] + sigmoidf_(a[2]) * bflo(pw.y); r[3] = h[3] + sigmoidf_(a[3]) * bfhi(pw.y);
                        *(f32x4*)(C + o) = r; }
                asm volatile("" ::: "memory"); }
    }
};
struct EpiSwiglu {
    static constexpr bool PERM = true;
    bf16* ACT; const float* b1;
    __device__ __forceinline__ void operator()(const f32x4 (&acc)[2][2][4][2], const Unit& u, int wr, int wc, int fr, int fq) const {
        const int jn = u.pn - u.e * 8;
        const int row0 = u.pm * BM + wr * 64 + fr, x0 = jn * 128 + wc * 32 + 8 * fq;
        const float* bg = b1 + (size_t)u.e * 2048 + x0; const float* bl = bg + 1024;
        const f32x4 g0 = *(const f32x4*)bg, g1 = *(const f32x4*)(bg + 4), l0 = *(const f32x4*)bl, l1 = *(const f32x4*)(bl + 4);
#pragma unroll
        for (int ai = 0; ai < 2; ++ai)
#pragma unroll
            for (int m = 0; m < 4; ++m) { float o[8];
#pragma unroll
                for (int n = 0; n < 2; ++n)
#pragma unroll
                    for (int j = 0; j < 4; ++j) { const float xg = fminf(acc[ai][0][m][n][j] + (n ? g1[j] : g0[j]), 7.0f); const float xl = fminf(fmaxf(acc[ai][1][m][n][j] + (n ? l1[j] : l0[j]), -7.0f), 7.0f);
                        o[n * 4 + j] = (xl + 1.0f) * (xg * sigmoidf_(1.702f * xg)); }
                u32x4 w; w.x = pk2(o[0], o[1]); w.y = pk2(o[2], o[3]); w.z = pk2(o[4], o[5]); w.w = pk2(o[6], o[7]);
                *(u32x4*)(ACT + (size_t)(row0 + ai * HALF + m * 16) * DFF + x0) = w; }
    }
};
struct EpiMoeOut {
    static constexpr bool PERM = true;
    bf16* YB; const float* b2; const int* RT; const float* GW; const unsigned* cnt;
    __device__ __forceinline__ void operator()(const f32x4 (&acc)[2][2][4][2], const Unit& u, int wr, int wc, int fr, int fq) const {
        const int jn = u.pn - u.e * 4;
        const int r0 = wr * 64 + fr, c0 = jn * BM + wc * 32 + 8 * fq;
        const int ne = (int)cnt[64 * u.e];
        const float* bp = b2 + (size_t)u.e * 1024 + c0;
        f32x4 bv[2][2];
#pragma unroll
        for (int bj = 0; bj < 2; ++bj)
#pragma unroll
            for (int n = 0; n < 2; ++n) bv[bj][n] = *(const f32x4*)(bp + bj * HALF + 4 * n);
#pragma unroll
        for (int ai = 0; ai < 2; ++ai)
#pragma unroll
            for (int m = 0; m < 4; ++m) { const int slot = u.aux + r0 + ai * HALF + m * 16;
                if (slot < ne) { const int dst = RT[(size_t)u.e * ECAP + slot]; const float gw = GW[dst]; bf16* rowp = YB + (size_t)dst * DM + c0;
#pragma unroll
                    for (int bj = 0; bj < 2; ++bj) { const f32x4 v0 = (acc[ai][bj][m][0] + bv[bj][0]) * gw, v1 = (acc[ai][bj][m][1] + bv[bj][1]) * gw;
                        u32x4 w; w.x = pk2(v0[0], v0[1]); w.y = pk2(v0[2], v0[3]); w.z = pk2(v1[0], v1[1]); w.w = pk2(v1[2], v1[3]);
                        *(u32x4*)(rowp + bj * HALF) = w; } } }
    }
};
struct MoeOrder {
    int G, c, NT, npan; const LAS int* pstart; const LAS int* rtab;
    __device__ __forceinline__ bool next(int i, Unit& u) const {
        const int L = i * G + c; if (L >= npan * NT) return false;
        const int panel = L / NT, jn = L - panel * NT; int e = 0;
        for (int q = 1; q < NEXP; ++q) e += (panel >= pstart[q]) ? 1 : 0;
        u.pm = panel; u.e = e; u.pn = e * NT + jn; u.aux = (panel - pstart[e]) * BM; return true;
    }
    __device__ __forceinline__ const LAS int* rowtab(int i) const { return rtab + i * 256; }
};
struct Args {
    const float* in[30]; float* out; unsigned char* ws; int ph_lo, ph_hi;
};
struct Frame {
    LAS unsigned char* lds;
    int tid, lane, wave, G, bid;
    unsigned* ctl;
};

template <int KS, bool SWAP>
__device__ __forceinline__ f32x4 mm_ll(const LAS bf16* A, int lda, const LAS bf16* Bt, int ldb, int lane, f32x4 acc) {
    const int r = lane & 15, g = lane >> 4;
#pragma unroll
    for (int ks = 0; ks < KS; ++ks) {
        const bf16x8 a = *(const LAS bf16x8*)(A + r * lda + ks * 32 + g * 8);
        const bf16x8 b = *(const LAS bf16x8*)(Bt + r * ldb + ks * 32 + g * 8);
        acc = SWAP ? __builtin_amdgcn_mfma_f32_16x16x32_bf16(b, a, acc, 0, 0, 0) : __builtin_amdgcn_mfma_f32_16x16x32_bf16(a, b, acc, 0, 0, 0);
    }
    return acc;
}
template <int KS, bool SWAP>
__device__ __forceinline__ f32x4 mm_lg(const LAS bf16* A, int lda, const bf16* Bt, int ldb, int lane, f32x4 acc) {
    const int r = lane & 15, g = lane >> 4;
#pragma unroll
    for (int ks = 0; ks < KS; ++ks) {
        const bf16x8 a = *(const LAS bf16x8*)(A + r * lda + ks * 32 + g * 8);
        const bf16x8 b = *(const bf16x8*)(Bt + (size_t)r * ldb + ks * 32 + g * 8);
        acc = SWAP ? __builtin_amdgcn_mfma_f32_16x16x32_bf16(b, a, acc, 0, 0, 0) : __builtin_amdgcn_mfma_f32_16x16x32_bf16(a, b, acc, 0, 0, 0);
    }
    return acc;
}
template <int KS, bool SWAP>
__device__ __forceinline__ f32x4 mm_gg(const bf16* A, int lda, const bf16* Bt, int ldb, int lane, f32x4 acc) {
    const int r = lane & 15, g = lane >> 4;
#pragma unroll
    for (int ks = 0; ks < KS; ++ks) {
        const bf16x8 a = *(const bf16x8*)(A + (size_t)r * lda + ks * 32 + g * 8);
        const bf16x8 b = *(const bf16x8*)(Bt + (size_t)r * ldb + ks * 32 + g * 8);
        acc = SWAP ? __builtin_amdgcn_mfma_f32_16x16x32_bf16(b, a, acc, 0, 0, 0) : __builtin_amdgcn_mfma_f32_16x16x32_bf16(a, b, acc, 0, 0, 0);
    }
    return acc;
}

__device__ __forceinline__ void transpose_item(const float* W, int ldw, int nvalid, int k0, int n0, bf16* WT, size_t dst_row0, int Kdst, LAS float* scr, int lane) {
    const int nn = n0 + (lane & 31); const bool ok = nn < nvalid;
#pragma unroll
    for (int i = 0; i < 32; ++i) { const int kk = 2 * i + (lane >> 5); scr[kk * 33 + (lane & 31)] = ok ? W[(size_t)(k0 + kk) * ldw + nn] : 0.f; }
    LDS_WAIT(); asm volatile("" ::: "memory");
    const int c = lane & 7;
#pragma unroll
    for (int j = 0; j < 4; ++j) { const int n = (lane >> 3) + 8 * j; const LAS float* s = scr + (8 * c) * 33 + n;
        u32x4 o; o.x = pk2(s[0 * 33], s[1 * 33]); o.y = pk2(s[2 * 33], s[3 * 33]); o.z = pk2(s[4 * 33], s[5 * 33]); o.w = pk2(s[6 * 33], s[7 * 33]);
        *(u32x4*)(WT + (dst_row0 + n) * Kdst + k0 + 8 * c) = o; }
    LDS_WAIT(); asm volatile("" ::: "memory");
}
__device__ __forceinline__ void rms_row_to_bf16(const float* xrow, const float* gain, bf16* orow, int lane) {
    const f32x4* xr = (const f32x4*)xrow + lane; const f32x4* gr = (const f32x4*)gain + lane;
    f32x4 v[4]; float s = 0.f;
#pragma unroll
    for (int j = 0; j < 4; ++j) { v[j] = xr[64 * j]; s += (v[j].x * v[j].x + v[j].y * v[j].y) + (v[j].z * v[j].z + v[j].w * v[j].w); }
    const float rs = 1.f / sqrtf(wave_sum(s) * (1.f / DM) + NORM_EPS);
    unsigned long long* o8 = (unsigned long long*)orow + lane;
#pragma unroll
    for (int j = 0; j < 4; ++j) { const f32x4 gg = gr[64 * j]; o8[64 * j] = (unsigned long long)pk2(v[j].x * rs * gg.x, v[j].y * rs * gg.y) | ((unsigned long long)pk2(v[j].z * rs * gg.z, v[j].w * rs * gg.w) << 32); }
}
__device__ __forceinline__ void p0_prologue(const Frame& F, const Args& a) {
    unsigned char* ws = a.ws;
    LAS float* scr = (LAS float*)(F.lds + F.wave * 16384);
    const int gw = F.bid * NWAVES + F.wave, NGW = F.G * NWAVES;
    constexpr int I_W1 = NEXP * 16 * 64, I_W2 = NEXP * 16 * 32, I_IN = 16 * 112, I_O = 16 * 32, I_G = 16 * 32, I_P = 4 * 32, I_L1 = 16, I_L2 = 16, I_L3 = 2 * 16;
    constexpr int NITEMS = I_W1 + I_W2 + I_IN + I_O + I_G + I_P + I_L1 + I_L2 + I_L3;
    for (int it = gw; it < NITEMS; it += NGW) {
        int r = it;
        if (r < I_W1) { const int e = r >> 10, q = r & 1023, kb = q >> 6, nb = q & 63, n0 = nb * 32, half = n0 >> 10, x = n0 & 1023;
            transpose_item(a.in[22] + (size_t)e * 1024 * 2048, 2048, 2048, kb * 64, n0, (bf16*)(ws + WS_W1T), (size_t)e * 2048 + (x >> 7) * 256 + half * 128 + (x & 127), 1024, scr, F.lane); continue; } r -= I_W1;
        if (r < I_W2) { const int e = r >> 9, q = r & 511, kb = q >> 5, nb = q & 31;
            transpose_item(a.in[24] + (size_t)e * 1024 * 1024, 1024, 1024, kb * 64, nb * 32, (bf16*)(ws + WS_W2T), (size_t)e * 1024 + nb * 32, 1024, scr, F.lane); continue; } r -= I_W2;
        if (r < I_IN) { const int kb = r / 112, nb = r % 112; transpose_item(a.in[3], IN_COLS, IN_COLS, kb * 64, nb * 32, (bf16*)(ws + WS_WINT), nb * 32, 1024, scr, F.lane); continue; } r -= I_IN;
        if (r < I_O) { transpose_item(a.in[18], 1024, 1024, (r >> 5) * 64, (r & 31) * 32, (bf16*)(ws + WS_WOUTT), (r & 31) * 32, 1024, scr, F.lane); continue; } r -= I_O;
        if (r < I_G) { transpose_item(a.in[27], 1024, 1024, (r >> 5) * 64, (r & 31) * 32, (bf16*)(ws + WS_WGT), (r & 31) * 32, 1024, scr, F.lane); continue; } r -= I_G;
        if (r < I_P) { transpose_item(a.in[28], 1024, 1024, (r >> 5) * 64, (r & 31) * 32, (bf16*)(ws + WS_WPT), (r & 31) * 32, 256, scr, F.lane); continue; } r -= I_P;
        if (r < I_L1) { transpose_item(a.in[6], 512, 512, 0, r * 32, (bf16*)(ws + WS_LW2T), r * 32, 64, scr, F.lane); continue; } r -= I_L1;
        if (r < I_L2) { transpose_item(a.in[8], 512, 512, 0, r * 32, (bf16*)(ws + WS_LA2T), r * 32, 64, scr, F.lane); continue; } r -= I_L2;
        transpose_item(a.in[9], 512, 512, (r >> 4) * 64, (r & 15) * 32, (bf16*)(ws + WS_LG2T), (r & 15) * 32, 128, scr, F.lane);
    }
    { const float* wr = a.in[20]; bf16* WH = (bf16*)(ws + WS_WRH); bf16* WL = (bf16*)(ws + WS_WRL);
      for (int i = F.bid * 512 + F.tid; i < NEXP * DM; i += F.G * 512) { const int e = i >> 10, k = i & 1023; const float w = wr[k * NEXP + e]; const unsigned hb = f2bf(w); WH[i] = (bf16)hb; WL[i] = (bf16)f2bf(w - bf2f(hb)); } }
    for (int m = gw; m < NTOK; m += NGW) rms_row_to_bf16(a.in[0] + (size_t)m * DM, a.in[2], (bf16*)(ws + WS_U) + (size_t)m * DM, F.lane);
    { const f32x4* ps = (const f32x4*)a.in[1]; u32x2* pd = (u32x2*)(ws + WS_PB);
      for (size_t i = (size_t)F.bid * 512 + F.tid; i < (size_t)NTOK * 256 / 4; i += (size_t)F.G * 512) { const f32x4 v = ps[i]; u32x2 o; o.x = pk2(v.x, v.y); o.y = pk2(v.z, v.w); pd[i] = o; } }
}

constexpr int RT_HI = 0, RT_LO = 33024, RT_PART = 66048, RT_LG = RT_PART + 8 * 16 * 33 * 4, RT_EX = RT_LG + 2048, RT_LDH = 1032;
__device__ __forceinline__ void p6_router(const Frame& F, const Args& a, unsigned* cntw, size_t rt_off, size_t gw_off) {
    unsigned char* ws = a.ws; LAS unsigned char* lds = F.lds;
    const float* H1 = (const float*)(ws + WS_H1); bf16* U = (bf16*)(ws + WS_U);
    const float* g = a.in[19]; const float* br = a.in[21];
    int* RT = (int*)(ws + rt_off); float* GW = (float*)(ws + gw_off);
    const int lane = F.lane, w = F.wave, r16 = lane & 15, g4 = lane >> 4;
    LAS bf16* HI = (LAS bf16*)(lds + RT_HI); LAS bf16* LO = (LAS bf16*)(lds + RT_LO); LAS float* PART = (LAS float*)(lds + RT_PART); LAS float* LG = (LAS float*)(lds + RT_LG); LAS float* EX = (LAS float*)(lds + RT_EX);
    bf16x8 bh[4][2], bl[4][2];
    { const bf16* WH = (const bf16*)(ws + WS_WRH); const bf16* WL = (const bf16*)(ws + WS_WRL);
#pragma unroll
      for (int ks = 0; ks < 4; ++ks)
#pragma unroll
          for (int n = 0; n < 2; ++n) { const size_t o = (size_t)(n * 16 + r16) * DM + (4 * w + ks) * 32 + g4 * 8; bh[ks][n] = *(const bf16x8*)(WH + o); bl[ks][n] = *(const bf16x8*)(WL + o); } }
    f32x4 gg[4];
#pragma unroll
    for (int j = 0; j < 4; ++j) gg[j] = *((const f32x4*)g + lane + 64 * j);
    const int ntile = NTOK / 16;
    f32x4 v[2][4];
    { const int t0 = F.bid; if (t0 < ntile) {
#pragma unroll
        for (int q = 0; q < 2; ++q)
#pragma unroll
            for (int j = 0; j < 4; ++j) v[q][j] = *((const f32x4*)(H1 + (size_t)(t0 * 16 + 2 * w + q) * DM) + lane + 64 * j); } }
    for (int tl = F.bid; tl < ntile; tl += F.G) {
#pragma unroll
        for (int q = 0; q < 2; ++q) { const int rr = 2 * w + q; const int m = tl * 16 + rr; float s = 0.f;
#pragma unroll
            for (int j = 0; j < 4; ++j) s += (v[q][j].x * v[q][j].x + v[q][j].y * v[q][j].y) + (v[q][j].z * v[q][j].z + v[q][j].w * v[q][j].w);
            const float rs = 1.f / sqrtf(wave_sum(s) * (1.f / DM) + NORM_EPS);
#pragma unroll
            for (int j = 0; j < 4; ++j) { const f32x4 y = v[q][j] * rs * gg[j];
                u32x2 h; h.x = pk2(y.x, y.y); h.y = pk2(y.z, y.w);
                u32x2 l; l.x = pk2(y.x - bflo(h.x), y.y - bfhi(h.x)); l.y = pk2(y.z - bflo(h.y), y.w - bfhi(h.y));
                *((u32x2*)(U + (size_t)m * DM) + lane + 64 * j) = h;
                *(LAS u32x2*)(HI + rr * RT_LDH + 4 * lane + 256 * j) = h; *(LAS u32x2*)(LO + rr * RT_LDH + 4 * lane + 256 * j) = l; } }
        { const int tn = tl + F.G; if (tn < ntile) {
#pragma unroll
            for (int q = 0; q < 2; ++q)
#pragma unroll
                for (int j = 0; j < 4; ++j) v[q][j] = *((const f32x4*)(H1 + (size_t)(tn * 16 + 2 * w + q) * DM) + lane + 64 * j); } }
        __syncthreads();
        { f32x4 acc[2]; acc[0] = (f32x4){0.f, 0.f, 0.f, 0.f}; acc[1] = acc[0];
#pragma unroll
          for (int ks = 0; ks < 4; ++ks) { const int ko = (4 * w + ks) * 32 + g4 * 8;
              const bf16x8 ah = *(const LAS bf16x8*)(HI + r16 * RT_LDH + ko), al = *(const LAS bf16x8*)(LO + r16 * RT_LDH + ko);
#pragma unroll
              for (int n = 0; n < 2; ++n) { acc[n] = __builtin_amdgcn_mfma_f32_16x16x32_bf16(ah, bh[ks][n], acc[n], 0, 0, 0); acc[n] = __builtin_amdgcn_mfma_f32_16x16x32_bf16(ah, bl[ks][n], acc[n], 0, 0, 0);
                  acc[n] = __builtin_amdgcn_mfma_f32_16x16x32_bf16(al, bh[ks][n], acc[n], 0, 0, 0); } }
#pragma unroll
          for (int n = 0; n < 2; ++n)
#pragma unroll
              for (int i = 0; i < 4; ++i) PART[(w * 16 + 4 * g4 + i) * 33 + n * 16 + r16] = acc[n][i]; }
        __syncthreads();
        { const int e = lane & 31, tk = 2 * w + (lane >> 5), m = tl * 16 + tk; float lg = br[e];
#pragma unroll
          for (int q = 0; q < 8; ++q) lg += PART[(q * 16 + tk) * 33 + e];
          LG[tk * 32 + e] = lg;
          LDS_WAIT(); asm volatile("" ::: "memory");
          int rank = 0; float mx = lg;
#pragma unroll
          for (int q = 0; q < 8; ++q) { const f32x4 o = *(const LAS f32x4*)(LG + tk * 32 + 4 * q);
#pragma unroll
              for (int i = 0; i < 4; ++i) { const int eo = 4 * q + i; rank += (o[i] > lg || (o[i] == lg && eo < e)) ? 1 : 0; mx = fmaxf(mx, o[i]); } }
          const float ex = __expf(lg - mx);
          if (rank < 4) EX[tk * 4 + rank] = ex;
          LDS_WAIT(); asm volatile("" ::: "memory");
          const f32x4 e4 = *(const LAS f32x4*)(EX + tk * 4);
          if (rank < 4) { const float gv = ex / ((e4[0] + e4[1]) + (e4[2] + e4[3]));
              const unsigned slot = __hip_atomic_fetch_add(cntw + 64 * e, 1u, RLX_AGENT);
              RT[(size_t)e * ECAP + slot] = m * 4 + rank; GW[m * 4 + rank] = gv; } }
        __syncthreads();
    }
}
__device__ __forceinline__ void p9_combine(const Frame& F, const Args& a) {
    unsigned char* ws = a.ws;
    float* H1 = (float*)(ws + WS_H1); bf16* U = (bf16*)(ws + WS_U); const bf16* YB = (const bf16*)(ws + WS_YB); const float* g = a.in[26];
    const int gw = F.bid * NWAVES + F.wave, NGW = F.G * NWAVES, lane = F.lane;
    for (int m = gw; m < NTOK; m += NGW) {
        f32x4* xr = (f32x4*)(H1 + (size_t)m * DM) + lane; const f32x4* gr = (const f32x4*)g + lane;
        f32x4 v[4]; float s = 0.f;
#pragma unroll
        for (int j = 0; j < 4; ++j) { v[j] = xr[64 * j];
#pragma unroll
            for (int k = 0; k < 4; ++k) { const u32x2 w = *((const u32x2*)(YB + ((size_t)m * 4 + k) * DM) + lane + 64 * j); v[j].x += bflo(w.x); v[j].y += bfhi(w.x); v[j].z += bflo(w.y); v[j].w += bfhi(w.y); }
            xr[64 * j] = v[j]; s += (v[j].x * v[j].x + v[j].y * v[j].y) + (v[j].z * v[j].z + v[j].w * v[j].w); }
        const float rs = 1.f / sqrtf(wave_sum(s) * (1.f / DM) + NORM_EPS);
        unsigned long long* o8 = (unsigned long long*)(U + (size_t)m * DM) + lane;
#pragma unroll
        for (int j = 0; j < 4; ++j) { const f32x4 gg = gr[64 * j]; o8[64 * j] = (unsigned long long)pk2(v[j].x * rs * gg.x, v[j].y * rs * gg.y) | ((unsigned long long)pk2(v[j].z * rs * gg.z, v[j].w * rs * gg.w) << 32); }
    }
}
__device__ __forceinline__ void p11_final(const Frame& F, const Args& a) {
    const float* g = a.in[29];
    const int gw = F.bid * NWAVES + F.wave, NGW = F.G * NWAVES, lane = F.lane;
    for (int m = gw; m < NTOK; m += NGW) {
        f32x4* xr = (f32x4*)(a.out + (size_t)m * DM) + lane; const f32x4* gr = (const f32x4*)g + lane;
        f32x4 v[4]; float s = 0.f;
#pragma unroll
        for (int j = 0; j < 4; ++j) { v[j] = xr[64 * j]; s += (v[j].x * v[j].x + v[j].y * v[j].y) + (v[j].z * v[j].z + v[j].w * v[j].w); }
        const float rs = 1.f / sqrtf(wave_sum(s) * (1.f / DM) + NORM_EPS);
#pragma unroll
        for (int j = 0; j < 4; ++j) { const f32x4 gg = gr[64 * j]; f32x4 y; y.x = v[j].x * rs * gg.x; y.y = v[j].y * rs * gg.y; y.z = v[j].z * rs * gg.z; y.w = v[j].w * rs * gg.w; xr[64 * j] = y; }
    }
}
__device__ __forceinline__ int moe_tables(const Frame& F, const Args& a, int NT, bool rows) {
    LAS int* pst = (LAS int*)(F.lds + MOE_TAB_OFF); LAS int* rtab = (LAS int*)(F.lds + MOE_ROWTAB_OFF);
    const int* RT = (const int*)(a.ws + WS_RT);
    if (F.tid == 0) { int acc = 0; for (int e = 0; e < NEXP; ++e) { pst[e] = acc; const int c = (int)__hip_atomic_load(F.ctl + CW_CNT + 64 * e, RLX_AGENT); pst[40 + e] = c; acc += (c + 255) >> 8; } pst[NEXP] = acc; }
    __syncthreads();
    const int npan = pst[NEXP];
    if (rows) {
        for (int i = 0; i < MAXU; ++i) { const int L = i * F.G + F.bid; if (L >= npan * NT) break;
            const int panel = L / NT; int e = 0; for (int q = 1; q < NEXP; ++q) e += (panel >= pst[q]) ? 1 : 0;
            if (F.tid < 256) { const int slot = (panel - pst[e]) * 256 + F.tid; rtab[i * 256 + F.tid] = (slot < pst[40 + e]) ? (RT[(size_t)e * ECAP + slot] >> 2) : 0; } }
    }
    __syncthreads();
    return npan;
}
constexpr int LD72 = 72, LDF = 68, LDL0 = 264;
constexpr int RW_Z = 0, RW_IA = 17408, RW_MAB = 0, RW_X1 = 17408;
constexpr int RW_L0 = 34816, RW_MAK = 34816, RW_MRB = 34816 + 9216, RW_MRK = 34816 + 18432;
constexpr int RW_AT = 68608, RW_RT = 77824, RW_BH = 87040, RW_KH = 96256, RW_XS0 = RW_BH;
constexpr int RW_BBT = 105472, RW_KBT = 114688, RW_VMT = 123904, RW_CS = 133120, RW_UT = 135168, RW_WT = 144384;
static_assert(RW_WT + 9216 <= MISC_OFF && RW_XS0 + 17408 <= RW_BBT, "rwkv LDS map");

#ifndef PROBE_DUP
#define PROBE_DUP -1
#endif
#define PREP(k) _Pragma("unroll") for (int prep_ = 0; prep_ < ((PROBE_DUP == (k)) ? 2 : 1); ++prep_)
__device__ __forceinline__ void st_bf16(LAS bf16* p, float v) { *p = (bf16)f2bf(v); }

__device__ __forceinline__ void rwkv_chunk_unit(const Frame& F, const Args& a, int unit) {
    unsigned char* ws = a.ws; LAS unsigned char* lds = F.lds;
    const int tid = F.tid, lane = F.lane, w = F.wave;
    const int b = unit >> 10, h = (unit >> 7) & 7, c = unit & 127;
    const int rowbase = b * SEQ + c * 64;
    const bf16* PROJ = (const bf16*)(ws + WS_PROJ);
    const float* mu = a.in[4];
    LAS bf16* L0 = (LAS bf16*)(lds + RW_L0);
    LAS float* Z = (LAS float*)(lds + RW_Z); LAS float* IA = (LAS float*)(lds + RW_IA);
    LAS float* MAB = (LAS float*)(lds + RW_MAB); LAS float* X1 = (LAS float*)(lds + RW_X1);
    LAS bf16* MAK = (LAS bf16*)(lds + RW_MAK); LAS bf16* MRB = (LAS bf16*)(lds + RW_MRB); LAS bf16* MRK = (LAS bf16*)(lds + RW_MRK);
    LAS bf16* AT_ = (LAS bf16*)(lds + RW_AT); LAS bf16* RT_ = (LAS bf16*)(lds + RW_RT); LAS bf16* BH_ = (LAS bf16*)(lds + RW_BH); LAS bf16* KH_ = (LAS bf16*)(lds + RW_KH);
    LAS bf16* WT = (LAS bf16*)(lds + RW_WT); LAS bf16* UT = (LAS bf16*)(lds + RW_UT);
    LAS bf16* BBT = (LAS bf16*)(lds + RW_BBT); LAS bf16* KBT = (LAS bf16*)(lds + RW_KBT); LAS bf16* VMT = (LAS bf16*)(lds + RW_VMT);
    LAS float* CS = (LAS float*)(lds + RW_CS);
    const int r16 = lane & 15, g4 = lane >> 4;

    PREP(20) {
    {
        const int t = tid >> 3, cg = tid & 7; const int row = rowbase + t;
        const u32x4* pc = (const u32x4*)(PROJ + (size_t)row * NPROJ + C_DW + cg * 32);
        const u32x4* pp = (const u32x4*)(PROJ + (size_t)(row - 1) * NPROJ + C_DW + cg * 32);
        const bool hasprev = (c > 0) || (t > 0);
        const f32x4* mp = (const f32x4*)(mu + C_DW + cg * 32);
        const float sc = cg < 2 ? 2.f : 1.f;
#pragma unroll
        for (int q = 0; q < 4; ++q) {
            const u32x4 xc = pc[q]; u32x4 xp = (u32x4){0u, 0u, 0u, 0u}; if (hasprev) xp = pp[q];
            const f32x4 m0 = mp[2 * q], m1 = mp[2 * q + 1];
            float hv[8];
            { const unsigned cw[4] = {xc.x, xc.y, xc.z, xc.w}, pw[4] = {xp.x, xp.y, xp.z, xp.w};
#pragma unroll
              for (int j = 0; j < 4; ++j) { const float x0 = bflo(cw[j]), x1 = bfhi(cw[j]), p0 = bflo(pw[j]), p1 = bfhi(pw[j]);
                  const float ma = (j < 2) ? m0[2 * j] : m1[2 * j - 4], mb = (j < 2) ? m0[2 * j + 1] : m1[2 * j - 3];
                  hv[2 * j] = x0 + (p0 - x0) * ma; hv[2 * j + 1] = x1 + (p1 - x1) * mb; } }
#pragma unroll
            for (int j = 0; j < 8; ++j) { const float y = sigmoidf_(hv[j] * sc); hv[j] = cg < 2 ? (2.f * y - 1.f) : (cg < 4 ? hv[j] : y); }
            u32x4 o; o.x = pk2(hv[0], hv[1]); o.y = pk2(hv[2], hv[3]); o.z = pk2(hv[4], hv[5]); o.w = pk2(hv[6], hv[7]);
            *(LAS u32x4*)(L0 + t * LDL0 + cg * 32 + q * 8) = o;
        }
    }
    __syncthreads();
    }
    PREP(21) {
    {
        const bf16* W2T = (const bf16*)(ws + WS_LW2T) + (size_t)h * 64 * 64; const bf16* A2T = (const bf16*)(ws + WS_LA2T) + (size_t)h * 64 * 64; const bf16* G2T = (const bf16*)(ws + WS_LG2T) + (size_t)h * 64 * 128;
        bf16* GATEB = (bf16*)(ws + WS_GATEB);
        for (int q = 0; q < 6; ++q) { const int T = w * 6 + q, which = T >> 4, tt = T & 15, m0 = (tt >> 2) * 16, n0 = (tt & 3) * 16;
            f32x4 acc = (f32x4){0.f, 0.f, 0.f, 0.f};
            if (which == 0) { acc = mm_lg<2, true>(L0 + m0 * LDL0, LDL0, W2T + n0 * 64, 64, lane, acc); *(LAS f32x4*)(Z + (m0 + r16) * LDF + n0 + 4 * g4) = acc; }
            else if (which == 1) { acc = mm_lg<2, true>(L0 + m0 * LDL0 + 64, LDL0, A2T + n0 * 64, 64, lane, acc); *(LAS f32x4*)(IA + (m0 + r16) * LDF + n0 + 4 * g4) = acc; }
            else { acc = mm_lg<4, true>(L0 + m0 * LDL0 + 128, LDL0, G2T + n0 * 128, 128, lane, acc);
                u32x2 o; o.x = pk2(acc[0], acc[1]); o.y = pk2(acc[2], acc[3]); *(u32x2*)(GATEB + (size_t)(rowbase + m0 + r16) * 512 + h * 64 + n0 + 4 * g4) = o; }
        }
    }
    __syncthreads();
    }
    PREP(22) {
    {
        const int d = lane, hd = h * 64 + d;
        const float mur = mu[C_RR + hd], muk = mu[C_RK + hd], muv = mu[C_RV + hd];
        const float w0 = a.in[5][hd], a0 = a.in[7][hd], kkw = a.in[10][hd], kaw = a.in[11][hd], rkw = a.in[12][hd];
        float rv[8], kv[8], vv[8], lw[8], av[8], kk[8], km[8];
        { const bf16* p0 = PROJ + (size_t)(rowbase + 8 * w - 1) * NPROJ + hd; const bool hasprev = (c > 0) || (w > 0);
          float pr = 0.f, pk = 0.f, pv = 0.f; if (hasprev) { pr = bf2f(p0[C_RR]); pk = bf2f(p0[C_RK]); pv = bf2f(p0[C_RV]); }
#pragma unroll
          for (int i = 0; i < 8; ++i) { const bf16* p = p0 + (size_t)(i + 1) * NPROJ; const float xr = bf2f(p[C_RR]), xk = bf2f(p[C_RK]), xv = bf2f(p[C_RV]);
              rv[i] = xr + (pr - xr) * mur; kv[i] = xk + (pk - xk) * muk; vv[i] = xv + (pv - xv) * muv; pr = xr; pk = xk; pv = xv; } }
        bf16* BONUSB = (bf16*)(ws + WS_BONUSB);
        float run = 0.f;
#pragma unroll
        for (int i = 0; i < 8; ++i) { const int t = 8 * w + i;
            const float z = Z[t * LDF + d] + w0; const float sp = __logf(1.f + __expf(-z)); const float wlog = -sp - 0.5f; lw[i] = -__expf(wlog);
            av[i] = sigmoidf_(IA[t * LDF + d] + a0);
            const float kr = kv[i] * kkw; const float n2 = wave_sum(kr * kr); kk[i] = kr / fmaxf(sqrtf(n2), 1e-12f);
            km[i] = kv[i] * (1.f + (av[i] - 1.f) * kaw);
            const float bs = wave_sum(rv[i] * km[i] * rkw);
            BONUSB[(size_t)(rowbase + t) * 512 + hd] = (bf16)f2bf(bs * vv[i]);
            run += lw[i]; lw[i] = run;
        }
        CS[w * 64 + d] = run;
        __syncthreads();
        float off = 0.f, tot = 0.f;
#pragma unroll
        for (int q = 0; q < 8; ++q) { const float s = CS[q * 64 + d]; tot += s; off += (q < w) ? s : 0.f; }
        if (w == 0) ((float*)(ws + WS_DV))[(size_t)unit * 64 + d] = __expf(tot);
        unsigned pb[4], pkk[4], pvv[4];
        float prevc = off;
#pragma unroll
        for (int i = 0; i < 8; ++i) { const int t = 8 * w + i;
            const float ct = off + lw[i];
            const float ec = __expf(ct), ecp = __expf(prevc), en = __expf(-ct), er = __expf(tot - ct);
            prevc = ct;
            const float be = kk[i] * av[i];
            st_bf16(AT_ + t * LD72 + d, -kk[i] * ecp); st_bf16(RT_ + t * LD72 + d, rv[i] * ec);
            st_bf16(BH_ + t * LD72 + d, be * en); st_bf16(KH_ + t * LD72 + d, km[i] * en);
            const unsigned xb = f2bf(be * er), xk = f2bf(km[i] * er), xv = f2bf(vv[i]);
            if (i & 1) { pb[i >> 1] |= xb << 16; pkk[i >> 1] |= xk << 16; pvv[i >> 1] |= xv << 16; } else { pb[i >> 1] = xb; pkk[i >> 1] = xk; pvv[i >> 1] = xv; }
        }
        *(LAS u32x4*)(BBT + d * LD72 + 8 * w) = (u32x4){pb[0], pb[1], pb[2], pb[3]};
        *(LAS u32x4*)(KBT + d * LD72 + 8 * w) = (u32x4){pkk[0], pkk[1], pkk[2], pkk[3]};
        *(LAS u32x4*)(VMT + d * LD72 + 8 * w) = (u32x4){pvv[0], pvv[1], pvv[2], pvv[3]};
    }
    __syncthreads();
    }
    PREP(23) {
    {
        const int mi = w >> 1;
        const LAS bf16* Am = (mi < 2) ? AT_ : RT_; const LAS bf16* Bm = (mi & 1) ? KH_ : BH_;
        LAS bf16* Om = (mi == 1) ? MAK : (mi == 2 ? MRB : MRK);
        for (int q = 0; q < 8; ++q) { const int tt = (w & 1) * 8 + q, mt = tt >> 2, ntl = tt & 3, m0 = mt * 16, n0 = ntl * 16;
            f32x4 acc = (f32x4){0.f, 0.f, 0.f, 0.f};
            if (ntl <= mt) acc = mm_ll<2, true>(Am + m0 * LD72, LD72, Bm + n0 * LD72, LD72, lane, acc);
            const int trow = m0 + r16;
#pragma unroll
            for (int i = 0; i < 4; ++i) { const int j = n0 + 4 * g4 + i; const bool keep = (mi < 2) ? (j < trow) : (j <= trow); acc[i] = keep ? acc[i] : 0.f; }
            if (mi == 0) *(LAS f32x4*)(MAB + trow * LDF + n0 + 4 * g4) = acc;
            else { u32x2 o; o.x = pk2(acc[0], acc[1]); o.y = pk2(acc[2], acc[3]); *(LAS u32x2*)(Om + trow * LD72 + n0 + 4 * g4) = o; }
        }
    }
    __syncthreads();
    }
    PREP(24) {
    {
#pragma unroll
        for (int q = 0; q < 2; ++q) { const int T = 2 * w + q, m0 = (T >> 2) * 16, n0 = (T & 3) * 16;
            f32x4 acc = (f32x4){0.f, 0.f, 0.f, 0.f};
            acc = mm_ll<2, true>(MAK + m0 * LD72, LD72, VMT + n0 * LD72, LD72, lane, acc);
            *(LAS f32x4*)(X1 + (m0 + r16) * LDF + n0 + 4 * g4) = acc; }
    }
    __syncthreads();
    }
    PREP(25) if (w < 2 && (prep_ == 0 || w == 0)) {
        LAS float* XS = (w == 0) ? (LAS float*)(lds + RW_XS0) : X1;
#pragma unroll 1
        for (int tb = 0; tb < 8; ++tb) {
            float acc[8];
#pragma unroll
            for (int i = 0; i < 8; ++i) acc[i] = (w == 0) ? bf2f(AT_[(8 * tb + i) * LD72 + lane]) : X1[(8 * tb + i) * LDF + lane];
#pragma unroll 1
            for (int jb = 0; jb < tb; ++jb) {
                float xj[8];
#pragma unroll
                for (int j = 0; j < 8; ++j) xj[j] = XS[(8 * jb + j) * LDF + lane];
#pragma unroll
                for (int i = 0; i < 8; ++i) { const f32x4 m0 = *(const LAS f32x4*)(MAB + (8 * tb + i) * LDF + 8 * jb), m1 = *(const LAS f32x4*)(MAB + (8 * tb + i) * LDF + 8 * jb + 4);
                    acc[i] += (m0[0] * xj[0] + m0[1] * xj[1]) + (m0[2] * xj[2] + m0[3] * xj[3]) + (m1[0] * xj[4] + m1[1] * xj[5]) + (m1[2] * xj[6] + m1[3] * xj[7]); }
            }
#pragma unroll
            for (int i = 1; i < 8; ++i) { const f32x4 m0 = *(const LAS f32x4*)(MAB + (8 * tb + i) * LDF + 8 * tb), m1 = *(const LAS f32x4*)(MAB + (8 * tb + i) * LDF + 8 * tb + 4);
#pragma unroll
                for (int j = 0; j < 8; ++j) if (j < i) acc[i] += ((j < 4) ? m0[j & 3] : m1[j & 3]) * acc[j]; }
#pragma unroll
            for (int i = 0; i < 8; ++i) XS[(8 * tb + i) * LDF + lane] = acc[i];
        }
        LAS bf16* O = (w == 0) ? WT : UT;
#pragma unroll 1
        for (int q = 0; q < 8; ++q) { float x[8];
#pragma unroll
            for (int i = 0; i < 8; ++i) x[i] = XS[(8 * q + i) * LDF + lane];
            u32x4 o; o.x = pk2(x[0], x[1]); o.y = pk2(x[2], x[3]); o.z = pk2(x[4], x[5]); o.w = pk2(x[6], x[7]);
            *(LAS u32x4*)(O + lane * LD72 + 8 * q) = o; }
    }
    __syncthreads();
    PREP(26) {
    {
        const int mt = w >> 1, m0 = mt * 16, sh = w & 1;
        { f32x4 c0 = (f32x4){0.f, 0.f, 0.f, 0.f}, c1 = c0;
          c0 = mm_ll<2, true>(BBT + m0 * LD72, LD72, WT + (32 * sh) * LD72, LD72, lane, c0);
          c1 = mm_ll<2, true>(BBT + m0 * LD72, LD72, WT + (32 * sh + 16) * LD72, LD72, lane, c1);
          u32x4 o; o.x = pk2(c0[0], c0[1]); o.y = pk2(c0[2], c0[3]); o.z = pk2(c1[0], c1[1]); o.w = pk2(c1[2], c1[3]);
          *((u32x4*)(ws + WS_PLT) + ((size_t)unit * 8 + mt * 2 + sh) * 64 + lane) = o; }
#pragma unroll
        for (int q = 0; q < 2; ++q) { const int vq = 2 * sh + q; f32x4 acc = (f32x4){0.f, 0.f, 0.f, 0.f};
            acc = mm_ll<2, false>(BBT + m0 * LD72, LD72, UT + (vq * 16) * LD72, LD72, lane, acc);
            acc = mm_ll<2, false>(KBT + m0 * LD72, LD72, VMT + (vq * 16) * LD72, LD72, lane, acc);
            *((f32x4*)(ws + WS_QT) + (((size_t)unit * 4 + vq) * 4 + mt) * 64 + lane) = acc; }
#pragma unroll
        for (int q = 0; q < 2; ++q) { const int n0 = (2 * sh + q) * 16; f32x4 acc = (f32x4){0.f, 0.f, 0.f, 0.f};
            acc = mm_ll<2, true>(MRB + m0 * LD72, LD72, WT + n0 * LD72, LD72, lane, acc);
            const u32x2 rr = *(const LAS u32x2*)(RT_ + (m0 + r16) * LD72 + n0 + 4 * g4);
            u32x2 o; o.x = pk2(acc[0] + bflo(rr.x), acc[1] + bfhi(rr.x)); o.y = pk2(acc[2] + bflo(rr.y), acc[3] + bfhi(rr.y));
            *(u32x2*)((bf16*)(ws + WS_GB) + (size_t)unit * 4096 + (m0 + r16) * 64 + n0 + 4 * g4) = o;
            f32x4 ol = (f32x4){0.f, 0.f, 0.f, 0.f};
            ol = mm_ll<2, true>(MRB + m0 * LD72, LD72, UT + n0 * LD72, LD72, lane, ol);
            ol = mm_ll<2, true>(MRK + m0 * LD72, LD72, VMT + n0 * LD72, LD72, lane, ol);
            *(f32x4*)((float*)(ws + WS_OL) + (size_t)unit * 4096 + (m0 + r16) * 64 + n0 + 4 * g4) = ol; }
    }
    __syncthreads();
    }
}

constexpr int GL_KBT = 0, GL_VT = 9216, GL_CS = 9216 + 18432;
constexpr int GL_QT = 32768, GL_KH = GL_QT + 9216, GL_ATT = GL_KH + 9216, GL_SS = GL_ATT + 9216;

__device__ __forceinline__ void gla_loga_octet(const Args& a, const bf16* PROJ, int rowbase, int h, int w, int d, float (&cl)[8]) {
    const float* gk2 = a.in[15]; const float gb = a.in[16][h * 64 + d];
    float wk[16];
#pragma unroll
    for (int j = 0; j < 16; ++j) wk[j] = gk2[j * 256 + h * 64 + d];
    float run = 0.f;
#pragma unroll
    for (int i = 0; i < 8; ++i) { const u32x4* dp = (const u32x4*)(PROJ + (size_t)(rowbase + 8 * w + i) * NPROJ + C_GD); const u32x4 d0 = dp[0], d1 = dp[1];
        const unsigned dw[8] = {d0.x, d0.y, d0.z, d0.w, d1.x, d1.y, d1.z, d1.w};
        float s = gb;
#pragma unroll
        for (int j = 0; j < 8; ++j) { s += bflo(dw[j]) * wk[2 * j]; s += bfhi(dw[j]) * wk[2 * j + 1]; }
        const float ls = fminf(s, 0.f) - __logf(1.f + __expf(-fabsf(s)));
        run += ls * (1.f / 16.f); cl[i] = run; }
}

__device__ __forceinline__ void gla_chunk_unit(const Frame& F, const Args& a, int unit) {
    unsigned char* ws = a.ws; LAS unsigned char* lds = F.lds;
    const int lane = F.lane, w = F.wave;
    const int b = unit >> 9, h = (unit >> 7) & 3, c = unit & 127;
    const int rowbase = b * SEQ + c * 64;
    const bf16* PROJ = (const bf16*)(ws + WS_PROJ);
    LAS bf16* KBT = (LAS bf16*)(lds + GL_KBT); LAS bf16* VT = (LAS bf16*)(lds + GL_VT); LAS float* CS = (LAS float*)(lds + GL_CS);
    const int r16 = lane & 15, g4 = lane >> 4;
    {
        const int d = lane; float cl[8];
        gla_loga_octet(a, PROJ, rowbase, h, w, d, cl);
        CS[w * 64 + d] = cl[7];
        __syncthreads();
        float off = 0.f, tot = 0.f;
#pragma unroll
        for (int q = 0; q < 8; ++q) { const float s = CS[q * 64 + d]; tot += s; off += (q < w) ? s : 0.f; }
        if (w == 0) ((float*)(ws + WS_GDEC))[(size_t)unit * 64 + d] = __expf(tot);
        unsigned pk_[4], pv0[4], pv1[4];
#pragma unroll
        for (int i = 0; i < 8; ++i) { const bf16* p = PROJ + (size_t)(rowbase + 8 * w + i) * NPROJ;
            const float kx = bf2f(p[C_GK + h * 64 + d]); const unsigned xk = f2bf(kx * __expf(tot - (off + cl[i])));
            const unsigned v0 = p[C_GV + h * 128 + d], v1 = p[C_GV + h * 128 + 64 + d];
            if (i & 1) { pk_[i >> 1] |= xk << 16; pv0[i >> 1] |= v0 << 16; pv1[i >> 1] |= v1 << 16; } else { pk_[i >> 1] = xk; pv0[i >> 1] = v0; pv1[i >> 1] = v1; } }
        *(LAS u32x4*)(KBT + d * LD72 + 8 * w) = (u32x4){pk_[0], pk_[1], pk_[2], pk_[3]};
        *(LAS u32x4*)(VT + d * LD72 + 8 * w) = (u32x4){pv0[0], pv0[1], pv0[2], pv0[3]};
        *(LAS u32x4*)(VT + (64 + d) * LD72 + 8 * w) = (u32x4){pv1[0], pv1[1], pv1[2], pv1[3]};
    }
    __syncthreads();
    {
        float* LS = (float*)(ws + WS_LS) + (size_t)unit * 8192;
#pragma unroll
        for (int q = 0; q < 4; ++q) { f32x4 acc = (f32x4){0.f, 0.f, 0.f, 0.f};
            acc = mm_ll<2, true>(VT + (w * 16) * LD72, LD72, KBT + (q * 16) * LD72, LD72, lane, acc);
            *(f32x4*)(LS + (w * 16 + r16) * 64 + q * 16 + 4 * g4) = acc; }
    }
    __syncthreads();
}

__device__ __forceinline__ void rwkv_scan_wave(const Args& a, int chain, int lane) {
    unsigned char* ws = a.ws;
    const int bh = chain >> 2, vq = chain & 3;
    const int r16 = lane & 15, g4 = lane >> 4;
    f32x4 acc[4];
#pragma unroll
    for (int m = 0; m < 4; ++m) acc[m] = (f32x4){0.f, 0.f, 0.f, 0.f};
    const u32x4* PLT = (const u32x4*)(ws + WS_PLT); const f32x4* QT = (const f32x4*)(ws + WS_QT); const float* DV = (const float*)(ws + WS_DV);
    bf16* S0 = (bf16*)(ws + WS_S0);
    u32x4 af[4][2], afn[4][2]; f32x4 qv[4], dv[4], qvn[4], dvn[4];
#define SCAN_LOAD(AF, QV, DVV, unit) do { _Pragma("unroll") for (int m = 0; m < 4; ++m) { _Pragma("unroll") for (int s = 0; s < 2; ++s) AF[m][s] = PLT[((unit) * 8 + m * 2 + s) * 64 + lane]; \
        QV[m] = QT[(((unit) * 4 + vq) * 4 + m) * 64 + lane]; DVV[m] = *(const f32x4*)(DV + (unit) * 64 + 16 * m + 4 * g4); } } while (0)
    { const size_t u0 = (size_t)bh * NCH; SCAN_LOAD(af, qv, dv, u0); }
    for (int c = 0; c < NCH; ++c) { const size_t unit = (size_t)bh * NCH + c;
        { const size_t un = (c + 1 < NCH) ? unit + 1 : unit; SCAN_LOAD(afn, qvn, dvn, un); }
        u32x2 pkd[4];
#pragma unroll
        for (int m = 0; m < 4; ++m) { pkd[m].x = pk2(acc[m][0], acc[m][1]); pkd[m].y = pk2(acc[m][2], acc[m][3]);
            *(u32x2*)(S0 + unit * 4096 + (size_t)(vq * 16 + r16) * 64 + 16 * m + 4 * g4) = pkd[m]; }
        bf16x8 bfr[2];
#pragma unroll
        for (int s = 0; s < 2; ++s) { const u32x4 t = (u32x4){pkd[2 * s].x, pkd[2 * s].y, pkd[2 * s + 1].x, pkd[2 * s + 1].y}; bfr[s] = __builtin_bit_cast(bf16x8, t); }
#pragma unroll
        for (int m = 0; m < 4; ++m) { f32x4 n = acc[m] * dv[m] + qv[m];
            n = __builtin_amdgcn_mfma_f32_16x16x32_bf16(__builtin_bit_cast(bf16x8, af[m][0]), bfr[0], n, 0, 0, 0);
            n = __builtin_amdgcn_mfma_f32_16x16x32_bf16(__builtin_bit_cast(bf16x8, af[m][1]), bfr[1], n, 0, 0, 0);
            acc[m] = n; }
#pragma unroll
        for (int m = 0; m < 4; ++m) { af[m][0] = afn[m][0]; af[m][1] = afn[m][1]; qv[m] = qvn[m]; dv[m] = dvn[m]; }
    }
#undef SCAN_LOAD
}
__device__ __forceinline__ void gla_scan_thread(const Args& a, int idx) {
    unsigned char* ws = a.ws;
    const int bh = idx >> 11, e4 = idx & 2047;
    const int dk4 = (e4 & 15) * 4;
    const f32x4* LS = (const f32x4*)(ws + WS_LS); const float* GD = (const float*)(ws + WS_GDEC); u32x2* SG = (u32x2*)(ws + WS_SG);
    f32x4 st = (f32x4){0.f, 0.f, 0.f, 0.f};
#pragma unroll 8
    for (int c = 0; c < NCH; ++c) { const size_t unit = (size_t)bh * NCH + c;
        const f32x4 ls = LS[unit * 2048 + e4]; const f32x4 gd = *(const f32x4*)(GD + unit * 64 + dk4);
        u32x2 o; o.x = pk2(st[0], st[1]); o.y = pk2(st[2], st[3]); SG[unit * 2048 + e4] = o;
        st = st * gd + ls; }
}

__device__ __forceinline__ void rwkv_out_wave(const Args& a, int unit, int lane) {
    unsigned char* ws = a.ws;
    const int b = unit >> 10, h = (unit >> 7) & 7, c = unit & 127; const int rowbase = b * SEQ + c * 64;
    const int r16 = lane & 15, g4 = lane >> 4;
    const bf16* GB = (const bf16*)(ws + WS_GB) + (size_t)unit * 4096; const bf16* S0 = (const bf16*)(ws + WS_S0) + (size_t)unit * 4096; const float* OL = (const float*)(ws + WS_OL) + (size_t)unit * 4096;
    const bf16* GATEB = (const bf16*)(ws + WS_GATEB); const bf16* BONUSB = (const bf16*)(ws + WS_BONUSB); bf16* YM = (bf16*)(ws + WS_YMIX);
    const float* gnw = a.in[13] + h * 64; const float* gnb = a.in[14] + h * 64;
    for (int mt = 0; mt < 4; ++mt) { const int m0 = mt * 16; const int t = m0 + r16;
        f32x4 o[4]; float s = 0.f;
#pragma unroll
        for (int nt = 0; nt < 4; ++nt) { f32x4 acc = *(const f32x4*)(OL + t * 64 + nt * 16 + 4 * g4);
            acc = mm_gg<2, true>(GB + m0 * 64, 64, S0 + (nt * 16) * 64, 64, lane, acc); o[nt] = acc; s += (acc[0] + acc[1]) + (acc[2] + acc[3]); }
        s += __shfl_xor(s, 16); s += __shfl_xor(s, 32);
        const float mean = s * (1.f / 64.f); float q = 0.f;
#pragma unroll
        for (int nt = 0; nt < 4; ++nt) { const f32x4 dd = o[nt] - mean; q += (dd[0] * dd[0] + dd[1] * dd[1]) + (dd[2] * dd[2] + dd[3] * dd[3]); }
        q += __shfl_xor(q, 16); q += __shfl_xor(q, 32);
        const float rstd = 1.f / sqrtf(q * (1.f / 64.f) + GN_EPS);
        const size_t ro = (size_t)(rowbase + t) * 512 + h * 64;
#pragma unroll
        for (int nt = 0; nt < 4; ++nt) { const int v0 = nt * 16 + 4 * g4;
            const f32x4 gw_ = *(const f32x4*)(gnw + v0), gb_ = *(const f32x4*)(gnb + v0);
            const u32x2 gt = *(const u32x2*)(GATEB + ro + v0), bn = *(const u32x2*)(BONUSB + ro + v0);
            const float y0 = ((o[nt][0] - mean) * rstd * gw_[0] + gb_[0] + bflo(bn.x)) * bflo(gt.x), y1 = ((o[nt][1] - mean) * rstd * gw_[1] + gb_[1] + bfhi(bn.x)) * bfhi(gt.x);
            const float y2 = ((o[nt][2] - mean) * rstd * gw_[2] + gb_[2] + bflo(bn.y)) * bflo(gt.y), y3 = ((o[nt][3] - mean) * rstd * gw_[3] + gb_[3] + bfhi(bn.y)) * bfhi(gt.y);
            u32x2 w; w.x = pk2(y0, y1); w.y = pk2(y2, y3);
            *(u32x2*)(YM + (size_t)(rowbase + t) * DM + h * 64 + v0) = w; }
    }
}
__device__ __forceinline__ void gla_out_unit(const Frame& F, const Args& a, int unit) {
    unsigned char* ws = a.ws; LAS unsigned char* lds = F.lds;
    const int lane = F.lane, w = F.wave;
    const int b = unit >> 9, h = (unit >> 7) & 3, c = unit & 127;
    const int rowbase = b * SEQ + c * 64;
    const bf16* PROJ = (const bf16*)(ws + WS_PROJ);
    LAS bf16* VT = (LAS bf16*)(lds + GL_VT); LAS float* CS = (LAS float*)(lds + GL_CS);
    LAS bf16* QT_ = (LAS bf16*)(lds + GL_QT); LAS bf16* KH_ = (LAS bf16*)(lds + GL_KH); LAS bf16* ATT = (LAS bf16*)(lds + GL_ATT); LAS float* SS = (LAS float*)(lds + GL_SS);
    const int r16 = lane & 15, g4 = lane >> 4;
    {
        const int d = lane; float cl[8];
        gla_loga_octet(a, PROJ, rowbase, h, w, d, cl);
        CS[w * 64 + d] = cl[7];
        __syncthreads();
        float off = 0.f;
#pragma unroll
        for (int q = 0; q < 8; ++q) { const float s = CS[q * 64 + d]; off += (q < w) ? s : 0.f; }
        unsigned pv0[4], pv1[4];
#pragma unroll
        for (int i = 0; i < 8; ++i) { const int t = 8 * w + i; const bf16* p = PROJ + (size_t)(rowbase + t) * NPROJ;
            const float bt = off + cl[i];
            const float qx = bf2f(p[C_GQ + h * 64 + d]) * 0.125f, kx = bf2f(p[C_GK + h * 64 + d]);
            st_bf16(QT_ + t * LD72 + d, qx * __expf(bt)); st_bf16(KH_ + t * LD72 + d, kx * __expf(-bt));
            const unsigned v0 = p[C_GV + h * 128 + d], v1 = p[C_GV + h * 128 + 64 + d];
            if (i & 1) { pv0[i >> 1] |= v0 << 16; pv1[i >> 1] |= v1 << 16; } else { pv0[i >> 1] = v0; pv1[i >> 1] = v1; } }
        *(LAS u32x4*)(VT + d * LD72 + 8 * w) = (u32x4){pv0[0], pv0[1], pv0[2], pv0[3]};
        *(LAS u32x4*)(VT + (64 + d) * LD72 + 8 * w) = (u32x4){pv1[0], pv1[1], pv1[2], pv1[3]};
    }
    __syncthreads();
    {
#pragma unroll
        for (int q = 0; q < 2; ++q) { const int T = 2 * w + q, mt = T >> 2, ntl = T & 3, m0 = mt * 16, n0 = ntl * 16;
            f32x4 acc = (f32x4){0.f, 0.f, 0.f, 0.f};
            if (ntl <= mt) acc = mm_ll<2, true>(QT_ + m0 * LD72, LD72, KH_ + n0 * LD72, LD72, lane, acc);
#pragma unroll
            for (int i = 0; i < 4; ++i) acc[i] = (n0 + 4 * g4 + i <= m0 + r16) ? acc[i] : 0.f;
            u32x2 o; o.x = pk2(acc[0], acc[1]); o.y = pk2(acc[2], acc[3]); *(LAS u32x2*)(ATT + (m0 + r16) * LD72 + n0 + 4 * g4) = o; }
    }
    __syncthreads();
    {
        const int mt = w >> 1, m0 = mt * 16, nh = w & 1; const int t = m0 + r16;
        const bf16* SG = (const bf16*)(ws + WS_SG) + (size_t)unit * 8192;
        f32x4 o[4]; float s = 0.f;
#pragma unroll
        for (int q = 0; q < 4; ++q) { const int n0 = (4 * nh + q) * 16; f32x4 acc = (f32x4){0.f, 0.f, 0.f, 0.f};
            acc = mm_lg<2, true>(QT_ + m0 * LD72, LD72, SG + (size_t)n0 * 64, 64, lane, acc);
            acc = mm_ll<2, true>(ATT + m0 * LD72, LD72, VT + n0 * LD72, LD72, lane, acc);
            o[q] = acc; s += (acc[0] * acc[0] + acc[1] * acc[1]) + (acc[2] * acc[2] + acc[3] * acc[3]); }
        s += __shfl_xor(s, 16); s += __shfl_xor(s, 32);
        if (g4 == 0) SS[t * 2 + nh] = s;
        __syncthreads();
        const float ms = (SS[t * 2] + SS[t * 2 + 1]) * (1.f / 128.f); const float rs = 1.f / sqrtf(ms + NORM_EPS);
        const float* ng = a.in[17] + h * 128; bf16* YM = (bf16*)(ws + WS_YMIX);
        const bf16* prow = PROJ + (size_t)(rowbase + t) * NPROJ + C_GG + h * 128;
#pragma unroll
        for (int q = 0; q < 4; ++q) { const int v0 = (4 * nh + q) * 16 + 4 * g4;
            const f32x4 gg = *(const f32x4*)(ng + v0); const u32x2 gw_ = *(const u32x2*)(prow + v0);
            const float g0 = bflo(gw_.x), g1 = bfhi(gw_.x), g2 = bflo(gw_.y), g3 = bfhi(gw_.y);
            const float y0 = o[q][0] * rs * gg[0] * (g0 * sigmoidf_(g0)), y1 = o[q][1] * rs * gg[1] * (g1 * sigmoidf_(g1));
            const float y2 = o[q][2] * rs * gg[2] * (g2 * sigmoidf_(g2)), y3 = o[q][3] * rs * gg[3] * (g3 * sigmoidf_(g3));
            u32x2 wv; wv.x = pk2(y0, y1); wv.y = pk2(y2, y3);
            *(u32x2*)(YM + (size_t)(rowbase + t) * DM + 512 + h * 128 + v0) = wv; }
    }
    __syncthreads();
}
#ifndef MK_SPLIT
#define MK_SPLIT 0
#endif
constexpr int NPHASE = 12;
#ifndef PROBE_DUP
#define PROBE_DUP -1
#endif
#define REP(k) _Pragma("unroll") for (int rep_ = 0; rep_ < ((PROBE_DUP == (k)) ? 2 : 1); ++rep_)
__global__ void __launch_bounds__(NWAVES * 64, 2) mega_fwd(Args args) {
    extern __shared__ __attribute__((aligned(16))) unsigned char lds_raw[];
    Frame F;
    F.lds = (LAS unsigned char*)lds_raw;
    F.tid = threadIdx.x; F.lane = F.tid & 63; F.wave = __builtin_amdgcn_readfirstlane(F.tid >> 6);
    F.G = gridDim.x; F.bid = blockIdx.x;
    F.ctl = (unsigned*)(args.ws + WS_CTL);
    volatile LAS unsigned* MISC = (volatile LAS unsigned*)(F.lds + MISC_OFF);
    if (F.tid < 16) MISC[F.tid] = 0u;
    __syncthreads();
    const int lo = args.ph_lo, hi = args.ph_hi;
    XcdBarrier bar; bar.bar = F.ctl + CW_BAR; bar.x = 0; bar.st = MISC;
    if (hi - lo > 1) bar = xcd_barrier_post(F.ctl + CW_BAR, MISC);
#ifndef PH_MASK
#define PH_MASK 0xFFF
#endif
#define IN(k) ((((PH_MASK) >> (k)) & 1) && lo <= (k) && (k) < hi)
#define SEAM(k) do { if (IN(k) && IN((k) + 1)) xcd_barrier(bar); } while (0)
    unsigned char* ws = args.ws;

    if (IN(0)) REP(0) { p0_prologue(F, args); __syncthreads(); }
    SEAM(0);
    if (IN(1)) REP(1) {
        { pg8::Gemm g{(const bf16*)(ws + WS_U), (const bf16*)(ws + WS_WINT), NTOK, NPROJ, DM}; pg8::StaticOrder S; S.init(NTOK, NPROJ, F.G, F.bid);
          EpiBf16 E{(bf16*)(ws + WS_PROJ), NPROJ};
          pg8::gemm_phase<EpiBf16, pg8::StaticOrder, false, true, true>(F.lds, g, S, E); }
        { pg8::Gemm g{(const bf16*)(ws + WS_PB), (const bf16*)(ws + WS_WPT), NTOK, DM, 256}; pg8::StaticOrder S; S.init(NTOK, DM, F.G, F.bid);
          EpiBf16 E{(bf16*)(ws + WS_PP), DM};
          pg8::gemm_phase<EpiBf16, pg8::StaticOrder, false, true, true>(F.lds, g, S, E); }
    }
    SEAM(1);
    if (IN(2)) REP(2) {
        for (int u = F.bid; u < RW_UNITS; u += F.G) rwkv_chunk_unit(F, args, u);
        REP(27) for (int u = F.bid; u < GL_UNITS; u += F.G) gla_chunk_unit(F, args, u);
    }
    SEAM(2);
    if (IN(3)) REP(3) {
        if (F.bid < 64) { if (F.wave == 0) rwkv_scan_wave(args, F.bid, F.lane); }
        else { for (int idx = (F.bid - 64) * 512 + F.tid; idx < NB * 4 * 2048; idx += (F.G - 64) * 512) gla_scan_thread(args, idx); }
    }
    SEAM(3);
    if (IN(4)) REP(4) {
        for (int u = F.bid * NWAVES + F.wave; u < RW_UNITS; u += F.G * NWAVES) rwkv_out_wave(args, u, F.lane);
        for (int u = F.bid; u < GL_UNITS; u += F.G) gla_out_unit(F, args, u);
    }
    SEAM(4);
    if (IN(5)) REP(5) {
        pg8::Gemm g{(const bf16*)(ws + WS_YMIX), (const bf16*)(ws + WS_WOUTT), NTOK, DM, DM}; pg8::StaticOrder S; S.init(NTOK, DM, F.G, F.bid);
        EpiResF32 E{args.in[0], (float*)(ws + WS_H1)};
        pg8::gemm_phase<EpiResF32, pg8::StaticOrder, false, false, true>(F.lds, g, S, E);
    }
    SEAM(5);
    if (IN(6)) { if (PROBE_DUP == 6) { p6_router(F, args, F.ctl + CW_CNT + 64 * 64, 690 * MiB, 693 * MiB); __syncthreads(); }
        p6_router(F, args, F.ctl + CW_CNT, WS_RT, WS_GW); __syncthreads(); }
    SEAM(6);
    if (IN(7)) REP(7) {
        const int npan = moe_tables(F, args, 8, true);
        pg8::Gemm g{(const bf16*)(ws + WS_U), (const bf16*)(ws + WS_W1T), NTOK, 2048, DM};
        MoeOrder S{F.G, F.bid, 8, npan, (const LAS int*)(F.lds + MOE_TAB_OFF), (const LAS int*)(F.lds + MOE_ROWTAB_OFF)};
        EpiSwiglu E{(bf16*)(ws + WS_ACT), args.in[23]};
        pg8::gemm_phase<EpiSwiglu, MoeOrder, true, true, true>(F.lds, g, S, E);
    }
    SEAM(7);
    if (IN(8)) REP(8) {
        const int npan = moe_tables(F, args, 4, false);
        pg8::Gemm g{(const bf16*)(ws + WS_ACT), (const bf16*)(ws + WS_W2T), NTOK, DM, DFF};
        MoeOrder S{F.G, F.bid, 4, npan, (const LAS int*)(F.lds + MOE_TAB_OFF), (const LAS int*)(F.lds + MOE_ROWTAB_OFF)};
        EpiMoeOut E{(bf16*)(ws + WS_YB), args.in[25], (const int*)(ws + WS_RT), (const float*)(ws + WS_GW), F.ctl + CW_CNT};
        pg8::gemm_phase<EpiMoeOut, MoeOrder, false, true, true>(F.lds, g, S, E);
    }
    SEAM(8);
    if (IN(9)) { p9_combine(F, args); }
    SEAM(9);
    if (IN(10)) REP(10) {
        pg8::Gemm g{(const bf16*)(ws + WS_U), (const bf16*)(ws + WS_WGT), NTOK, DM, DM}; pg8::StaticOrder S; S.init(NTOK, DM, F.G, F.bid);
        EpiGate E{(const float*)(ws + WS_H1), (const bf16*)(ws + WS_PP), args.out};
        pg8::gemm_phase<EpiGate, pg8::StaticOrder, false, false, true>(F.lds, g, S, E);
    }
    SEAM(10);
    if (IN(11)) { p11_final(F, args); }
#undef IN
#undef SEAM
}

extern "C" void kernel_launch(void* const* d_in, const int* in_sizes, int n_in, void* d_out, int out_size, void* d_ws, size_t ws_size, hipStream_t stream) {
    static int grid = 0;
    if (grid == 0) {
        if (n_in != 30 || out_size != NTOK * DM || ws_size < WS_END) { fprintf(stderr, "kernel_launch: unexpected shapes (n_in %d, out %d, ws %zu)\n", n_in, out_size, ws_size); grid = -1; return; }
        int dev = 0, cus = 0, per_cu = 0;
        if (hipGetDevice(&dev) != hipSuccess || hipDeviceGetAttribute(&cus, hipDeviceAttributeMultiprocessorCount, dev) != hipSuccess) { grid = -1; return; }
        if (hipFuncSetAttribute((const void*)mega_fwd, hipFuncAttributeMaxDynamicSharedMemorySize, LDS_BYTES) != hipSuccess) { fprintf(stderr, "kernel_launch: hipFuncSetAttribute failed\n"); grid = -1; return; }
        if (hipOccupancyMaxActiveBlocksPerMultiprocessor(&per_cu, (const void*)mega_fwd, NWAVES * 64, LDS_BYTES) != hipSuccess || per_cu < 1) { fprintf(stderr, "kernel_launch: occupancy query says %d blocks per CU\n", per_cu); }
        (void)hipGetLastError();
        grid = cus;
    }
    if (grid < 0) return;
    if (hipMemsetAsync((char*)d_ws + WS_CTL, 0, CTL_ZERO_BYTES, stream) != hipSuccess) return;
    Args a{};
    for (int i = 0; i < 30; ++i) a.in[i] = (const float*)d_in[i];
    a.out = (float*)d_out; a.ws = (unsigned char*)d_ws;
#if MK_SPLIT
    for (int p = 0; p < NPHASE; ++p) { a.ph_lo = p; a.ph_hi = p + 1; hipLaunchKernelGGL(mega_fwd, dim3(grid), dim3(NWAVES * 64), LDS_BYTES, stream, a); }
#else
    a.ph_lo = 0; a.ph_hi = NPHASE; hipLaunchKernelGGL(mega_fwd, dim3(grid), dim3(NWAVES * 64), LDS_BYTES, stream, a);
#endif
}
```

```cpp
#define PROBE_DUP -1
#include <hip/hip_runtime.h>
#include <cstdio>
#include <cstdint>

#define LAS __attribute__((address_space(3)))
typedef unsigned short bf16;
typedef short bf16x8 __attribute__((ext_vector_type(8)));
typedef float f32x4 __attribute__((ext_vector_type(4)));
typedef float f32x2 __attribute__((ext_vector_type(2)));
typedef unsigned u32x4 __attribute__((ext_vector_type(4)));
typedef unsigned u32x2 __attribute__((ext_vector_type(2)));

namespace pg8 {
constexpr int BM = 256, BK = 64, HALF = 128, HTB = HALF * BK * 2, STAGE_BYTES = 8 * HTB, NXCD = 8, WGM = 8;
__host__ __device__ __forceinline__ int lds_byte(int r, int c) { const int st = (r >> 4) * 2 + (c >> 5), rr = r & 15, cc = c & 31, ob = rr * 64 + cc * 2; return st * 1024 + (ob ^ (((ob >> 9) & 1) << 5)); }
__host__ __device__ __forceinline__ void stage_rc(int b, int& R, int& C) { const int st = b / 1024, sb = b % 1024, swz = sb ^ (((sb >> 9) & 1) << 5); R = (st >> 1) * 16 + swz / 64; C = (st & 1) * 32 + (swz % 64) / 2; }
__host__ __device__ __forceinline__ int perm32(int rho) { const int n = rho >> 4, i = rho & 15; return 8 * (i >> 2) + 4 * n + (i & 3); }

struct Unit { int pm, pn, e, aux; };
struct Gemm { const bf16* A; const bf16* Bt; int M, N, K; };

struct StaticOrder {
    int nM, nN, nwg, G, c;
    __host__ __device__ void init(int M, int N, int G_, int c_) { nM = M / BM; nN = N / BM; nwg = nM * nN; G = G_; c = c_; }
    __host__ __device__ bool next(int i, Unit& u) const {
        const long L = (long)i * G + c; if (L >= nwg) return false;
        int wgid = (int)L; { const int q = nwg / NXCD, r = nwg % NXCD, xcd = wgid % NXCD, off = wgid / NXCD; wgid = (xcd < r ? xcd * (q + 1) : r * (q + 1) + (xcd - r) * q) + off; }
        const int nig = WGM * nN, gid = wgid / nig, fm = gid * WGM, gsz = (nM - fm) < WGM ? (nM - fm) : WGM;
        u.pm = fm + ((wgid % nig) % gsz); u.pn = (wgid % nig) / gsz; u.e = 0; u.aux = 0; return true;
    }
    __device__ __forceinline__ const LAS int* rowtab(int) const { return nullptr; }
};

typedef __bf16 bf16x2_t __attribute__((ext_vector_type(2)));
__device__ __forceinline__ unsigned cvt_pk_bf16(float lo, float hi) { const f32x2 v = {lo, hi}; const bf16x2_t r = __builtin_convertvector(v, bf16x2_t); return __builtin_bit_cast(unsigned, r); }


template <class Epi, class Sched, bool GATHER, bool ALIGN_EPI, bool SP2>
__device__ __forceinline__ void gemm_phase(LAS unsigned char* lds, const Gemm g, const Sched& S, const Epi& E) {
    const int tid = threadIdx.x, wid = __builtin_amdgcn_readfirstlane(tid >> 6), lane = tid & 63, wr = wid >> 2, wc = wid & 3, fr = lane & 15, fq = lane >> 4;
    const int K = g.K, nt = K / BK;
    unsigned voffA[2], voffB[2]; int stR[2], stC[2];
#pragma unroll
    for (int i = 0; i < 2; ++i) { int R, C; stage_rc(tid * 16 + i * 8192, R, C); const int Rb = Epi::PERM ? ((R & ~31) + perm32(R & 31)) : R;
        voffA[i] = (unsigned)(R * K + C) * 2u; voffB[i] = (unsigned)(Rb * K + C) * 2u; stR[i] = R; stC[i] = C; }
    unsigned gvc[2][2], gvn[2][2];
    const size_t kstep = (size_t)(BK * 2);
    const size_t hstep = (size_t)HALF * K * 2;
    const size_t tstep = 2 * hstep;
    const unsigned ldsw = (unsigned)wid * 1024u;
    const int aoff = lds_byte(wr * 64 + fr, fq * 8), boff = lds_byte(wc * 32 + fr, fq * 8);
#define PG8_SA(b, h) (((b) * 2 + (h)) * HTB)
#define PG8_SB(b, h) ((4 + (b) * 2 + (h)) * HTB)
#define PG8_STAGE(bufoff, gbase, voff) do { _Pragma("unroll") for (int _i = 0; _i < 2; ++_i) \
        __builtin_amdgcn_global_load_lds((const unsigned*)((const char*)(gbase) + (voff)[_i]), (LAS unsigned*)(lds + (bufoff) + ldsw + _i * 8192), 16, 0, 0); } while (0)
#define PG8_STAGE_A(bufoff, p, h, nx) do { if constexpr (GATHER) { unsigned _v[2]; _v[0] = (nx) ? gvn[h][0] : gvc[h][0]; _v[1] = (nx) ? gvn[h][1] : gvc[h][1]; PG8_STAGE(bufoff, p, _v); } \
        else { PG8_STAGE(bufoff, (p) + (h) * hstep, voffA); } } while (0)
#define PG8_LDA(dst, b, h) do { _Pragma("unroll") for (int m = 0; m < 4; ++m) _Pragma("unroll") for (int k = 0; k < 2; ++k) dst[m][k] = *(const LAS bf16x8*)(lds + PG8_SA(b, h) + aoff + m * 2048 + k * 1024); } while (0)
#define PG8_LDB(dst, b, h) do { _Pragma("unroll") for (int n = 0; n < 2; ++n) _Pragma("unroll") for (int k = 0; k < 2; ++k) dst[n][k] = *(const LAS bf16x8*)(lds + PG8_SB(b, h) + boff + n * 2048 + k * 1024); } while (0)
#define PG8_MMA(ai, bj, At, Bt) do { __builtin_amdgcn_s_setprio(1); _Pragma("unroll") for (int m = 0; m < 4; ++m) _Pragma("unroll") for (int n = 0; n < 2; ++n) _Pragma("unroll") for (int k = 0; k < 2; ++k) \
        acc[ai][bj][m][n] = __builtin_amdgcn_mfma_f32_16x16x32_bf16(Bt[n][k], At[m][k], acc[ai][bj][m][n], 0, 0, 0); __builtin_amdgcn_s_setprio(0); } while (0)
#define PG8_WAIT_V(n) asm volatile("s_waitcnt vmcnt(" #n ")" ::: "memory")
#define PG8_WAIT_L(n) asm volatile("s_waitcnt lgkmcnt(" #n ")" ::: "memory")
#define PG8_BAR __builtin_amdgcn_s_barrier()
#define PG8_SCHED __builtin_amdgcn_sched_barrier(0)
#define PG8_GV(dst, tab) do { _Pragma("unroll") for (int _h = 0; _h < 2; ++_h) _Pragma("unroll") for (int _i = 0; _i < 2; ++_i) \
        dst[_h][_i] = (unsigned)((tab)[_h * HALF + stR[_i]] * K + stC[_i]) * 2u; } while (0)
    Unit cur, nxt; int ui = 0;
    if (!S.next(0, cur)) return;
    f32x4 acc[2][2][4][2];
#pragma unroll
    for (int a = 0; a < 2; ++a)
#pragma unroll
        for (int b = 0; b < 2; ++b)
#pragma unroll
            for (int m = 0; m < 4; ++m)
#pragma unroll
                for (int n = 0; n < 2; ++n) acc[a][b][m][n] = (f32x4){0.f, 0.f, 0.f, 0.f};
    bf16x8 At[4][2], B0[2][2], B1[2][2];
    const char* cA = GATHER ? (const char*)g.A : (const char*)g.A + (size_t)cur.pm * tstep; const char* cB = (const char*)g.Bt + (size_t)cur.pn * tstep;
    if constexpr (GATHER) { const LAS int* tab = S.rowtab(0); PG8_GV(gvc, tab);
#pragma unroll
        for (int h = 0; h < 2; ++h) { gvn[h][0] = gvc[h][0]; gvn[h][1] = gvc[h][1]; } }
    if constexpr (SP2) {
        PG8_STAGE(PG8_SB(0, 0), cB, voffB); PG8_STAGE(PG8_SB(0, 1), cB + hstep, voffB); PG8_STAGE_A(PG8_SA(0, 0), cA, 0, false); PG8_STAGE_A(PG8_SA(0, 1), cA, 1, false);
        if (wr == 1) PG8_BAR;
        PG8_WAIT_V(2); PG8_BAR;
        PG8_STAGE(PG8_SB(1, 0), cB + kstep, voffB); PG8_STAGE_A(PG8_SA(1, 0), cA + kstep, 0, false); PG8_STAGE(PG8_SB(1, 1), cB + hstep + kstep, voffB);
        PG8_WAIT_V(6); PG8_BAR;
    } else {
        PG8_STAGE(PG8_SB(0, 0), cB, voffB); PG8_STAGE_A(PG8_SA(0, 0), cA, 0, false); PG8_STAGE(PG8_SB(0, 1), cB + hstep, voffB); PG8_STAGE_A(PG8_SA(0, 1), cA, 1, false);
        if (wr == 1) PG8_BAR;
        PG8_WAIT_V(4); PG8_BAR;
        PG8_STAGE(PG8_SB(1, 0), cB + kstep, voffB); PG8_STAGE_A(PG8_SA(1, 0), cA + kstep, 0, false); PG8_STAGE(PG8_SB(1, 1), cB + hstep + kstep, voffB);
        PG8_WAIT_V(6); PG8_BAR;
    }
    for (;;) {
        const bool has_next = S.next(ui + 1, nxt);
        if constexpr (GATHER) { if (has_next) { const LAS int* tab = S.rowtab(ui + 1); PG8_GV(gvn, tab); } }
        const char* nA = GATHER ? (const char*)g.A : (has_next ? (const char*)g.A + (size_t)nxt.pm * tstep : cA); const char* nB = has_next ? (const char*)g.Bt + (size_t)nxt.pn * tstep : cB;
        for (int t = 0; t < nt; t += 2) {
            const bool last = (t == nt - 2);
            const bool nx = last && has_next;
            const char* a1 = cA + (size_t)(t + 1) * kstep;
            const char* a2 = last ? nA : cA + (size_t)(t + 2) * kstep; const char* b2 = last ? nB : cB + (size_t)(t + 2) * kstep;
            const char* a3 = a2 + kstep; const char* b3 = b2 + kstep;
            if constexpr (SP2) {
            PG8_LDB(B0, 0, 0); PG8_LDB(B1, 0, 1); PG8_SCHED; PG8_LDA(At, 0, 0); PG8_STAGE_A(PG8_SA(1, 1), a1, 1, false);
            PG8_WAIT_V(8); PG8_WAIT_L(0); PG8_BAR; PG8_MMA(0, 0, At, B0); PG8_MMA(0, 1, At, B1); PG8_BAR; PG8_SCHED;
            PG8_LDA(At, 0, 1); PG8_STAGE(PG8_SB(0, 0), b2, voffB); PG8_STAGE(PG8_SB(0, 1), b2 + hstep, voffB); PG8_STAGE_A(PG8_SA(0, 0), a2, 0, nx);
            PG8_WAIT_V(8); PG8_WAIT_L(0); PG8_BAR; PG8_MMA(1, 0, At, B0); PG8_MMA(1, 1, At, B1); PG8_BAR; PG8_SCHED;
            PG8_LDB(B0, 1, 0); PG8_LDB(B1, 1, 1); PG8_SCHED; PG8_LDA(At, 1, 0); PG8_STAGE_A(PG8_SA(0, 1), a2, 1, nx);
            PG8_WAIT_V(8); PG8_WAIT_L(0); PG8_BAR; PG8_MMA(0, 0, At, B0); PG8_MMA(0, 1, At, B1); PG8_BAR; PG8_SCHED;
            PG8_LDA(At, 1, 1); PG8_STAGE(PG8_SB(1, 0), b3, voffB); PG8_STAGE(PG8_SB(1, 1), b3 + hstep, voffB); PG8_STAGE_A(PG8_SA(1, 0), a3, 0, nx);
            PG8_WAIT_V(8); PG8_WAIT_L(0); PG8_BAR; PG8_MMA(1, 0, At, B0); PG8_MMA(1, 1, At, B1); PG8_BAR; PG8_SCHED;
            } else {
            PG8_LDB(B0, 0, 0); PG8_SCHED; PG8_LDA(At, 0, 0); PG8_STAGE_A(PG8_SA(1, 1), a1, 1, false);
            PG8_WAIT_L(8); PG8_BAR; PG8_WAIT_L(0); PG8_MMA(0, 0, At, B0); PG8_BAR; PG8_SCHED;
            PG8_LDB(B1, 0, 1); PG8_STAGE(PG8_SB(0, 0), b2, voffB);
            PG8_BAR; PG8_WAIT_L(0); PG8_MMA(0, 1, At, B1); PG8_BAR;
            PG8_LDA(At, 0, 1); PG8_STAGE_A(PG8_SA(0, 0), a2, 0, nx);
            PG8_BAR; PG8_WAIT_L(0); PG8_MMA(1, 0, At, B0); PG8_BAR; PG8_SCHED;
            PG8_STAGE(PG8_SB(0, 1), b2 + hstep, voffB);
            PG8_WAIT_V(6); PG8_BAR; PG8_MMA(1, 1, At, B1); PG8_BAR;
            PG8_LDB(B0, 1, 0); PG8_SCHED; PG8_LDA(At, 1, 0); PG8_STAGE_A(PG8_SA(0, 1), a2, 1, nx);
            PG8_WAIT_L(8); PG8_BAR; PG8_WAIT_L(0); PG8_MMA(0, 0, At, B0); PG8_BAR; PG8_SCHED;
            PG8_LDB(B1, 1, 1); PG8_STAGE(PG8_SB(1, 0), b3, voffB);
            PG8_BAR; PG8_WAIT_L(0); PG8_MMA(0, 1, At, B1); PG8_BAR;
            PG8_LDA(At, 1, 1); PG8_STAGE_A(PG8_SA(1, 0), a3, 0, nx);
            PG8_BAR; PG8_WAIT_L(0); PG8_MMA(1, 0, At, B0); PG8_BAR; PG8_SCHED;
            PG8_STAGE(PG8_SB(1, 1), b3 + hstep, voffB);
            PG8_WAIT_V(6); PG8_BAR; PG8_MMA(1, 1, At, B1); PG8_BAR;
            }
        }
        if constexpr (ALIGN_EPI) { if (wr == 0) PG8_BAR; }
        E(acc, cur, wr, wc, fr, fq);
        if (!has_next) break;
#pragma unroll
        for (int a = 0; a < 2; ++a)
#pragma unroll
            for (int b = 0; b < 2; ++b)
#pragma unroll
                for (int m = 0; m < 4; ++m)
#pragma unroll
                    for (int n = 0; n < 2; ++n) acc[a][b][m][n] = (f32x4){0.f, 0.f, 0.f, 0.f};
        cur = nxt; cA = nA; cB = nB; ++ui;
        if constexpr (GATHER) {
#pragma unroll
            for (int h = 0; h < 2; ++h) { gvc[h][0] = gvn[h][0]; gvc[h][1] = gvn[h][1]; } }
        if constexpr (ALIGN_EPI) { if (wr == 1) PG8_BAR; }
    }
    PG8_WAIT_V(0);
    if constexpr (!ALIGN_EPI) { if (wr == 0) PG8_BAR; }
    PG8_BAR;
#undef PG8_SA
#undef PG8_SB
#undef PG8_STAGE
#undef PG8_STAGE_A
#undef PG8_LDA
#undef PG8_LDB
#undef PG8_MMA
#undef PG8_WAIT_V
#undef PG8_WAIT_L
#undef PG8_BAR
#undef PG8_SCHED
#undef PG8_GV
}
}
constexpr int NTOK = 16384, DM = 1024, SEQ = 8192, NB = 2;
constexpr int NPROJ = 3584;
constexpr int IN_COLS = 3344;
constexpr int C_RR = 0, C_RK = 512, C_RV = 1024, C_DW = 1536, C_DA = 1600, C_DG = 1664;
constexpr int C_GQ = 1792, C_GK = 2048, C_GV = 2304, C_GG = 2816, C_GD = 3328;
constexpr int NEXP = 32, DFF = 1024, ECAP = 16384;
constexpr int NCH = 128;
constexpr int RW_UNITS = NB * 8 * NCH;
constexpr int GL_UNITS = NB * 4 * NCH;
constexpr int NWAVES = 8;
constexpr float NORM_EPS = 1e-6f, GN_EPS = 64e-5f;

constexpr size_t MiB = 1u << 20;
constexpr size_t WS_CTL = 0, CTL_ZERO_BYTES = 1 * MiB;
constexpr size_t WS_WINT = 2 * MiB;
constexpr size_t WS_WOUTT = 10 * MiB, WS_WGT = 12 * MiB, WS_WPT = 14 * MiB;
constexpr size_t WS_LW2T = 15 * MiB, WS_LA2T = WS_LW2T + 65536, WS_LG2T = WS_LA2T + 65536;
constexpr size_t WS_WRH = WS_LG2T + 131072, WS_WRL = WS_WRH + 65536;
constexpr size_t WS_W1T = 16 * MiB;
constexpr size_t WS_W2T = 144 * MiB;
constexpr size_t WS_U = 208 * MiB;
constexpr size_t WS_PB = 240 * MiB;
constexpr size_t WS_PP = 248 * MiB;
constexpr size_t WS_PROJ = 280 * MiB;
constexpr size_t WS_GATEB = 392 * MiB, WS_BONUSB = 408 * MiB;
constexpr size_t WS_PLT = 424 * MiB;
constexpr size_t WS_DV = 440 * MiB;
constexpr size_t WS_QT = 441 * MiB;
constexpr size_t WS_GB = 473 * MiB;
constexpr size_t WS_OL = 489 * MiB;
constexpr size_t WS_S0 = 521 * MiB;
constexpr size_t WS_LS = 537 * MiB;
constexpr size_t WS_GDEC = 569 * MiB;
constexpr size_t WS_SG = 570 * MiB;
constexpr size_t WS_YMIX = 586 * MiB;
constexpr size_t WS_H1 = 618 * MiB;
constexpr size_t WS_RT = 682 * MiB;
constexpr size_t WS_GW = 684 * MiB;
constexpr size_t WS_ACT = 280 * MiB;
constexpr size_t WS_YB = 424 * MiB;
constexpr size_t WS_END = 686 * MiB;
constexpr int CW_BAR = 4096;
constexpr int CW_CNT = 8192;

constexpr int RING_BYTES = 131072;
constexpr int LDS_BYTES = 160 * 1024;
constexpr int MISC_OFF = LDS_BYTES - 64;
constexpr int MOE_TAB_OFF = RING_BYTES;
constexpr int MOE_ROWTAB_OFF = RING_BYTES + 512;
constexpr int MAXU = 16;
static_assert(MOE_ROWTAB_OFF + MAXU * 1024 <= MISC_OFF, "LDS map");

#define RLX_AGENT __ATOMIC_RELAXED, __HIP_MEMORY_SCOPE_AGENT
#define LDS_WAIT() asm volatile("s_waitcnt lgkmcnt(0)" ::: "memory")
#define VM_WAIT() asm volatile("s_waitcnt vmcnt(0)" ::: "memory")

__device__ __forceinline__ float bf2f(unsigned v) { return __uint_as_float(v << 16); }
__device__ __forceinline__ unsigned pk2(float lo, float hi) { return pg8::cvt_pk_bf16(lo, hi); }
__device__ __forceinline__ unsigned f2bf(float f) { return pg8::cvt_pk_bf16(f, 0.f) & 0xffffu; }
__device__ __forceinline__ float bflo(unsigned w) { return __uint_as_float(w << 16); }
__device__ __forceinline__ float bfhi(unsigned w) { return __uint_as_float(w & 0xffff0000u); }
template <int CTRL> __device__ __forceinline__ float dppx(float v) { return __int_as_float(__builtin_amdgcn_update_dpp(0, __float_as_int(v), CTRL, 0xf, 0xf, true)); }
__device__ __forceinline__ float rdlane(float v, int l) { return __int_as_float(__builtin_amdgcn_readlane(__float_as_int(v), l)); }
__device__ __forceinline__ float wave_sum(float v) {
    v += dppx<0xB1>(v); v += dppx<0x4E>(v); v += dppx<0x141>(v); v += dppx<0x140>(v);
    return (rdlane(v, 0) + rdlane(v, 16)) + (rdlane(v, 32) + rdlane(v, 48));
}
__device__ __forceinline__ float frcp(float x) { return __builtin_amdgcn_rcpf(x); }
__device__ __forceinline__ float frsq(float x) { return __builtin_amdgcn_rsqf(x); }
__device__ __forceinline__ float sigmoidf_(float x) { return frcp(1.0f + __expf(-x)); }

#define XB_TMO      128
#define XB_XCNT(j)  (256  + 64 * (j))
#define XB_XSUB(j)  (1280 + 64 * (j))
#define XB_XGEN(j)  (2304 + 64 * (j))
#define XB_TOP      3328
#define XB_TOPGEN   3392
#define XCD_BAR_WORDS 3456
#define XB_SPIN_CAP (1u << 22)
__device__ __forceinline__ unsigned xb_ld(unsigned* p)              { return __hip_atomic_load(p, __ATOMIC_RELAXED, __HIP_MEMORY_SCOPE_AGENT); }
__device__ __forceinline__ unsigned xb_add(unsigned* p, unsigned v) { return __hip_atomic_fetch_add(p, v, __ATOMIC_RELAXED, __HIP_MEMORY_SCOPE_AGENT); }
__device__ __forceinline__ unsigned xb_xcc_id() { return (unsigned)__builtin_amdgcn_s_getreg((3 << 11) | 20) & 0xFu; }
#define XB_SPIN(cond, bar) do { unsigned _sp = 0; while (cond) { __builtin_amdgcn_s_sleep(1); \
    if ((++_sp & 255u) == 0u) { if (xb_ld(&(bar)[XB_TMO])) break; if (_sp > XB_SPIN_CAP) { atomicAdd(&(bar)[XB_TMO], 1u); break; } } } } while (0)
struct XcdBarrier { unsigned* bar; unsigned x; volatile LAS unsigned* st; };
__device__ __forceinline__ XcdBarrier xcd_barrier_post(unsigned* bar, volatile LAS unsigned* st) {
    XcdBarrier b; b.bar = bar; b.x = xb_xcc_id(); b.st = st;
    if (threadIdx.x == 0) (void)xb_add(&bar[XB_XCNT(b.x)], 1u);
    return b;
}
__device__ __forceinline__ void xcd_barrier_complete(unsigned* bar, unsigned x, unsigned& nloc, unsigned& nx) {
    const unsigned G = gridDim.x * gridDim.y * gridDim.z;
    unsigned sum, cnt, mine, sp = 0u;
    for (;;) {
        sum = 0u; cnt = 0u; mine = 0u;
#pragma unroll
        for (unsigned j = 0; j < 16; ++j) { const unsigned c = xb_ld(&bar[XB_XCNT(j)]); sum += c; cnt += (c > 0u) ? 1u : 0u; mine = (j == x) ? c : mine; }
        if (sum == G) break;
        __builtin_amdgcn_s_sleep(1);
        if ((++sp & 255u) == 0u) { if (xb_ld(&bar[XB_TMO])) break; if (sp > XB_SPIN_CAP) { atomicAdd(&bar[XB_TMO], 1u); break; } }
    }
    nloc = mine > 0u ? mine : 1u; nx = cnt > 0u ? cnt : 1u;
}
__device__ __forceinline__ void xcd_barrier(const XcdBarrier& b) {
    asm volatile("s_waitcnt vmcnt(0)" ::: "memory");
    __syncthreads();
    if (threadIdx.x == 0) {
        unsigned* bar = b.bar;
        __builtin_amdgcn_s_waitcnt(0);
        unsigned nloc = b.st[0], nx = b.st[1];
        if (nloc == 0u) { xcd_barrier_complete(bar, b.x, nloc, nx); b.st[0] = nloc; b.st[1] = nx; }
        const unsigned old = xb_add(&bar[XB_XSUB(b.x)], 1u);
        const unsigned gen = old / nloc;
        if (old + 1u == (gen + 1u) * nloc) {
            __builtin_amdgcn_fence(__ATOMIC_RELEASE, "agent");
            asm volatile("s_waitcnt vmcnt(0)" ::: "memory");
            const unsigned og = xb_add(&bar[XB_TOP], 1u);
            const unsigned tg = og / nx;
            if (og + 1u == (tg + 1u) * nx) xb_add(&bar[XB_TOPGEN], 1u);
            else XB_SPIN(xb_ld(&bar[XB_TOPGEN]) == tg, bar);
            __builtin_amdgcn_fence(__ATOMIC_ACQUIRE, "agent");
            xb_add(&bar[XB_XGEN(b.x)], 1u);
            asm volatile("s_waitcnt vmcnt(0)" ::: "memory");
        } else {
            XB_SPIN(xb_ld(&bar[XB_XGEN(b.x)]) == gen, bar);
            __builtin_amdgcn_fence(__ATOMIC_ACQUIRE, "agent");
            asm volatile("s_waitcnt vmcnt(0)" ::: "memory");
        }
    }
    __syncthreads();
}

using pg8::Unit; using pg8::HALF; using pg8::BM;
struct EpiBf16 {
    static constexpr bool PERM = true;
    bf16* O; int ldc;
    __device__ __forceinline__ void operator()(const f32x4 (&acc)[2][2][4][2], const Unit& u, int wr, int wc, int fr, int fq) const {
        const int row0 = u.pm * BM + wr * 64 + fr, col0 = u.pn * BM + wc * 32 + 8 * fq;
#pragma unroll
        for (int ai = 0; ai < 2; ++ai)
#pragma unroll
            for (int m = 0; m < 4; ++m) { bf16* rowp = O + (size_t)(row0 + ai * HALF + m * 16) * ldc + col0;
#pragma unroll
                for (int bj = 0; bj < 2; ++bj) { const f32x4 v0 = acc[ai][bj][m][0], v1 = acc[ai][bj][m][1];
                    u32x4 w; w.x = pk2(v0[0], v0[1]); w.y = pk2(v0[2], v0[3]); w.z = pk2(v1[0], v1[1]); w.w = pk2(v1[2], v1[3]);
                    *(u32x4*)(rowp + bj * HALF) = w; } }
    }
};
struct EpiResF32 {
    static constexpr bool PERM = false;
    const float* R; float* C;
    __device__ __forceinline__ void operator()(const f32x4 (&acc)[2][2][4][2], const Unit& u, int wr, int wc, int fr, int fq) const {
        const int row0 = u.pm * BM + wr * 64 + fr, col0 = u.pn * BM + wc * 32 + 4 * fq;
#pragma unroll
        for (int ai = 0; ai < 2; ++ai)
#pragma unroll
            for (int m = 0; m < 4; ++m) { const size_t off = (size_t)(row0 + ai * HALF + m * 16) * DM + col0;
#pragma unroll
                for (int bj = 0; bj < 2; ++bj)
#pragma unroll
                    for (int n = 0; n < 2; ++n) { const f32x4 r = *(const f32x4*)(R + off + bj * HALF + n * 16); *(f32x4*)(C + off + bj * HALF + n * 16) = r + acc[ai][bj][m][n]; }
                asm volatile("" ::: "memory"); }
    }
};
struct EpiGate {
    static constexpr bool PERM = false;
    const float* H; const bf16* PP; float* C;
    __device__ __forceinline__ void operator()(const f32x4 (&acc)[2][2][4][2], const Unit& u, int wr, int wc, int fr, int fq) const {
        const int row0 = u.pm * BM + wr * 64 + fr, col0 = u.pn * BM + wc * 32 + 4 * fq;
#pragma unroll
        for (int ai = 0; ai < 2; ++ai)
#pragma unroll
            for (int m = 0; m < 4; ++m) { const size_t off = (size_t)(row0 + ai * HALF + m * 16) * DM + col0;
#pragma unroll
                for (int bj = 0; bj < 2; ++bj)
#pragma unroll
                    for (int n = 0; n < 2; ++n) { const size_t o = off + bj * HALF + n * 16; const f32x4 h = *(const f32x4*)(H + o); const u32x2 pw = *(const u32x2*)(PP + o); const f32x4 a = acc[ai][bj][m][n];
                        f32x4 r; r[0] = h[0] + sigmoidf_(a[0]) * bflo(pw.x); r[1] = h[1] + sigmoidf_(a[1]) * bfhi(pw.x); r[2] = h[2] + sigmoidf_(a[2]) * bflo(pw.y); r[3] = h[3] + sigmoidf_(a[3]) * bfhi(pw.y);
                        *(f32x4*)(C + o) = r; }
                asm volatile("" ::: "memory"); }
    }
};
struct EpiSwiglu {
    static constexpr bool PERM = true;
    bf16* ACT; const float* b1;
    __device__ __forceinline__ void operator()(const f32x4 (&acc)[2][2][4][2], const Unit& u, int wr, int wc, int fr, int fq) const {
        const int jn = u.pn - u.e * 8;
        const int row0 = u.pm * BM + wr * 64 + fr, x0 = jn * 128 + wc * 32 + 8 * fq;
        const float* bg = b1 + (size_t)u.e * 2048 + x0; const float* bl = bg + 1024;
        const f32x4 g0 = *(const f32x4*)bg, g1 = *(const f32x4*)(bg + 4), l0 = *(const f32x4*)bl, l1 = *(const f32x4*)(bl + 4);
#pragma unroll
        for (int ai = 0; ai < 2; ++ai)
#pragma unroll
            for (int m = 0; m < 4; ++m) { float o[8];
#pragma unroll
                for (int n = 0; n < 2; ++n)
#pragma unroll
                    for (int j = 0; j < 4; ++j) { const float xg = fminf(acc[ai][0][m][n][j] + (n ? g1[j] : g0[j]), 7.0f); const float xl = fminf(fmaxf(acc[ai][1][m][n][j] + (n ? l1[j] : l0[j]), -7.0f), 7.0f);
                        o[n * 4 + j] = (xl + 1.0f) * (xg * sigmoidf_(1.702f * xg)); }
                u32x4 w; w.x = pk2(o[0], o[1]); w.y = pk2(o[2], o[3]); w.z = pk2(o[4], o[5]); w.w = pk2(o[6], o[7]);
                *(u32x4*)(ACT + (size_t)(row0 + ai * HALF + m * 16) * DFF + x0) = w; }
    }
};
struct EpiMoeOut {
    static constexpr bool PERM = true;
    bf16* YB; const float* b2; const int* RT; const float* GW; const unsigned* cnt;
    __device__ __forceinline__ void operator()(const f32x4 (&acc)[2][2][4][2], const Unit& u, int wr, int wc, int fr, int fq) const {
        const int jn = u.pn - u.e * 4;
        const int r0 = wr * 64 + fr, c0 = jn * BM + wc * 32 + 8 * fq;
        const int ne = (int)cnt[64 * u.e];
        const float* bp = b2 + (size_t)u.e * 1024 + c0;
        f32x4 bv[2][2];
#pragma unroll
        for (int bj = 0; bj < 2; ++bj)
#pragma unroll
            for (int n = 0; n < 2; ++n) bv[bj][n] = *(const f32x4*)(bp + bj * HALF + 4 * n);
#pragma unroll
        for (int ai = 0; ai < 2; ++ai)
#pragma unroll
            for (int m = 0; m < 4; ++m) { const int slot = u.aux + r0 + ai * HALF + m * 16;
                if (slot < ne) { const int dst = RT[(size_t)u.e * ECAP + slot]; const float gw = GW[dst]; bf16* rowp = YB + (size_t)dst * DM + c0;
#pragma unroll
                    for (int bj = 0; bj < 2; ++bj) { const f32x4 v0 = (acc[ai][bj][m][0] + bv[bj][0]) * gw, v1 = (acc[ai][bj][m][1] + bv[bj][1]) * gw;
                        u32x4 w; w.x = pk2(v0[0], v0[1]); w.y = pk2(v0[2], v0[3]); w.z = pk2(v1[0], v1[1]); w.w = pk2(v1[2], v1[3]);
                        *(u32x4*)(rowp + bj * HALF) = w; } } }
    }
};
struct MoeOrder {
    int G, c, NT, npan; const LAS int* pstart; const LAS int* rtab;
    __device__ __forceinline__ bool next(int i, Unit& u) const {
        const int L = i * G + c; if (L >= npan * NT) return false;
        const int panel = L / NT, jn = L - panel * NT; int e = 0;
        for (int q = 1; q < NEXP; ++q) e += (panel >= pstart[q]) ? 1 : 0;
        u.pm = panel; u.e = e; u.pn = e * NT + jn; u.aux = (panel - pstart[e]) * BM; return true;
    }
    __device__ __forceinline__ const LAS int* rowtab(int i) const { return rtab + i * 256; }
};
struct Args {
    const float* in[30]; float* out; unsigned char* ws; int ph_lo, ph_hi, rp, pad;
};
struct Frame {
    LAS unsigned char* lds;
    int tid, lane, wave, G, bid;
    unsigned* ctl;
};

template <int KS, bool SWAP>
__device__ __forceinline__ f32x4 mm_ll(const LAS bf16* A, int lda, const LAS bf16* Bt, int ldb, int lane, f32x4 acc) {
    const int r = lane & 15, g = lane >> 4;
#pragma unroll
    for (int ks = 0; ks < KS; ++ks) {
        const bf16x8 a = *(const LAS bf16x8*)(A + r * lda + ks * 32 + g * 8);
        const bf16x8 b = *(const LAS bf16x8*)(Bt + r * ldb + ks * 32 + g * 8);
        acc = SWAP ? __builtin_amdgcn_mfma_f32_16x16x32_bf16(b, a, acc, 0, 0, 0) : __builtin_amdgcn_mfma_f32_16x16x32_bf16(a, b, acc, 0, 0, 0);
    }
    return acc;
}
template <int KS, bool SWAP>
__device__ __forceinline__ f32x4 mm_lg(const LAS bf16* A, int lda, const bf16* Bt, int ldb, int lane, f32x4 acc) {
    const int r = lane & 15, g = lane >> 4;
#pragma unroll
    for (int ks = 0; ks < KS; ++ks) {
        const bf16x8 a = *(const LAS bf16x8*)(A + r * lda + ks * 32 + g * 8);
        const bf16x8 b = *(const bf16x8*)(Bt + (size_t)r * ldb + ks * 32 + g * 8);
        acc = SWAP ? __builtin_amdgcn_mfma_f32_16x16x32_bf16(b, a, acc, 0, 0, 0) : __builtin_amdgcn_mfma_f32_16x16x32_bf16(a, b, acc, 0, 0, 0);
    }
    return acc;
}
template <int KS, bool SWAP>
__device__ __forceinline__ f32x4 mm_gg(const bf16* A, int lda, const bf16* Bt, int ldb, int lane, f32x4 acc) {
    const int r = lane & 15, g = lane >> 4;
#pragma unroll
    for (int ks = 0; ks < KS; ++ks) {
        const bf16x8 a = *(const bf16x8*)(A + (size_t)r * lda + ks * 32 + g * 8);
        const bf16x8 b = *(const bf16x8*)(Bt + (size_t)r * ldb + ks * 32 + g * 8);
        acc = SWAP ? __builtin_amdgcn_mfma_f32_16x16x32_bf16(b, a, acc, 0, 0, 0) : __builtin_amdgcn_mfma_f32_16x16x32_bf16(a, b, acc, 0, 0, 0);
    }
    return acc;
}

__device__ __forceinline__ void transpose_item(const float* W, int ldw, int nvalid, int k0, int n0, bf16* WT, size_t dst_row0, int Kdst, LAS float* scr, int lane) {
    const int nn = n0 + (lane & 31); const bool ok = nn < nvalid;
#pragma unroll 8
    for (int i = 0; i < 32; ++i) { const int kk = 2 * i + (lane >> 5); scr[kk * 33 + (lane & 31)] = ok ? W[(size_t)(k0 + kk) * ldw + nn] : 0.f; }
    LDS_WAIT(); asm volatile("" ::: "memory");
    const int c = lane & 7;
#pragma unroll
    for (int j = 0; j < 4; ++j) { const int n = (lane >> 3) + 8 * j; const LAS float* s = scr + (8 * c) * 33 + n;
        u32x4 o; o.x = pk2(s[0 * 33], s[1 * 33]); o.y = pk2(s[2 * 33], s[3 * 33]); o.z = pk2(s[4 * 33], s[5 * 33]); o.w = pk2(s[6 * 33], s[7 * 33]);
        *(u32x4*)(WT + (dst_row0 + n) * Kdst + k0 + 8 * c) = o; }
    LDS_WAIT(); asm volatile("" ::: "memory");
}
__device__ __forceinline__ void rms_row_to_bf16(const float* xrow, const float* gain, bf16* orow, int lane) {
    const f32x4* xr = (const f32x4*)xrow + lane; const f32x4* gr = (const f32x4*)gain + lane;
    f32x4 v[4]; float s = 0.f;
#pragma unroll
    for (int j = 0; j < 4; ++j) { v[j] = xr[64 * j]; s += (v[j].x * v[j].x + v[j].y * v[j].y) + (v[j].z * v[j].z + v[j].w * v[j].w); }
    const float rs = frsq(wave_sum(s) * (1.f / DM) + NORM_EPS);
    unsigned long long* o8 = (unsigned long long*)orow + lane;
#pragma unroll
    for (int j = 0; j < 4; ++j) { const f32x4 gg = gr[64 * j]; o8[64 * j] = (unsigned long long)pk2(v[j].x * rs * gg.x, v[j].y * rs * gg.y) | ((unsigned long long)pk2(v[j].z * rs * gg.z, v[j].w * rs * gg.w) << 32); }
}
__device__ __forceinline__ void p0_prologue(const Frame& F, const Args& a) {
    unsigned char* ws = a.ws;
    LAS float* scr = (LAS float*)(F.lds + F.wave * 16384);
    const int gw = F.bid * NWAVES + F.wave, NGW = F.G * NWAVES;
    constexpr int I_W1 = NEXP * 16 * 64, I_W2 = NEXP * 16 * 32, I_IN = 16 * 112, I_O = 16 * 32, I_G = 16 * 32, I_P = 4 * 32, I_L1 = 16, I_L2 = 16, I_L3 = 2 * 16;
    constexpr int NITEMS = I_W1 + I_W2 + I_IN + I_O + I_G + I_P + I_L1 + I_L2 + I_L3;
    for (int it = gw; it < NITEMS; it += NGW) {
        int r = it;
        if (r < I_W1) { const int e = r >> 10, q = r & 1023, kb = q >> 6, nb = q & 63, n0 = nb * 32, half = n0 >> 10, x = n0 & 1023;
            transpose_item(a.in[22] + (size_t)e * 1024 * 2048, 2048, 2048, kb * 64, n0, (bf16*)(ws + WS_W1T), (size_t)e * 2048 + (x >> 7) * 256 + half * 128 + (x & 127), 1024, scr, F.lane); continue; } r -= I_W1;
        if (r < I_W2) { const int e = r >> 9, q = r & 511, kb = q >> 5, nb = q & 31;
            transpose_item(a.in[24] + (size_t)e * 1024 * 1024, 1024, 1024, kb * 64, nb * 32, (bf16*)(ws + WS_W2T), (size_t)e * 1024 + nb * 32, 1024, scr, F.lane); continue; } r -= I_W2;
        if (r < I_IN) { const int kb = r / 112, nb = r % 112; transpose_item(a.in[3], IN_COLS, IN_COLS, kb * 64, nb * 32, (bf16*)(ws + WS_WINT), nb * 32, 1024, scr, F.lane); continue; } r -= I_IN;
        if (r < I_O) { transpose_item(a.in[18], 1024, 1024, (r >> 5) * 64, (r & 31) * 32, (bf16*)(ws + WS_WOUTT), (r & 31) * 32, 1024, scr, F.lane); continue; } r -= I_O;
        if (r < I_G) { transpose_item(a.in[27], 1024, 1024, (r >> 5) * 64, (r & 31) * 32, (bf16*)(ws + WS_WGT), (r & 31) * 32, 1024, scr, F.lane); continue; } r -= I_G;
        if (r < I_P) { transpose_item(a.in[28], 1024, 1024, (r >> 5) * 64, (r & 31) * 32, (bf16*)(ws + WS_WPT), (r & 31) * 32, 256, scr, F.lane); continue; } r -= I_P;
        if (r < I_L1) { transpose_item(a.in[6], 512, 512, 0, r * 32, (bf16*)(ws + WS_LW2T), r * 32, 64, scr, F.lane); continue; } r -= I_L1;
        if (r < I_L2) { transpose_item(a.in[8], 512, 512, 0, r * 32, (bf16*)(ws + WS_LA2T), r * 32, 64, scr, F.lane); continue; } r -= I_L2;
        transpose_item(a.in[9], 512, 512, (r >> 4) * 64, (r & 15) * 32, (bf16*)(ws + WS_LG2T), (r & 15) * 32, 128, scr, F.lane);
    }
    { const float* wr = a.in[20]; bf16* WH = (bf16*)(ws + WS_WRH); bf16* WL = (bf16*)(ws + WS_WRL);
      for (int i = F.bid * 512 + F.tid; i < NEXP * DM; i += F.G * 512) { const int e = i >> 10, k = i & 1023; const float w = wr[k * NEXP + e]; const unsigned hb = f2bf(w); WH[i] = (bf16)hb; WL[i] = (bf16)f2bf(w - bf2f(hb)); } }
    for (int m = gw; m < NTOK; m += NGW) rms_row_to_bf16(a.in[0] + (size_t)m * DM, a.in[2], (bf16*)(ws + WS_U) + (size_t)m * DM, F.lane);
    { const f32x4* ps = (const f32x4*)a.in[1]; u32x2* pd = (u32x2*)(ws + WS_PB);
      for (size_t i = (size_t)F.bid * 512 + F.tid; i < (size_t)NTOK * 256 / 4; i += (size_t)F.G * 512) { const f32x4 v = ps[i]; u32x2 o; o.x = pk2(v.x, v.y); o.y = pk2(v.z, v.w); pd[i] = o; } }
}

constexpr int RT_HI = 0, RT_LO = 33024, RT_PART = 66048, RT_LG = RT_PART + 8 * 16 * 33 * 4, RT_EX = RT_LG + 2048, RT_LDH = 1032;
__device__ __forceinline__ void p6_router(const Frame& F, const Args& a, unsigned* cntw, size_t rt_off, size_t gw_off) {
    unsigned char* ws = a.ws; LAS unsigned char* lds = F.lds;
    const float* H1 = (const float*)(ws + WS_H1); bf16* U = (bf16*)(ws + WS_U);
    const float* g = a.in[19]; const float* br = a.in[21];
    int* RT = (int*)(ws + rt_off); float* GW = (float*)(ws + gw_off);
    const int lane = F.lane, w = F.wave, r16 = lane & 15, g4 = lane >> 4;
    LAS bf16* HI = (LAS bf16*)(lds + RT_HI); LAS bf16* LO = (LAS bf16*)(lds + RT_LO); LAS float* PART = (LAS float*)(lds + RT_PART); LAS float* LG = (LAS float*)(lds + RT_LG); LAS float* EX = (LAS float*)(lds + RT_EX);
    bf16x8 bh[4][2], bl[4][2];
    { const bf16* WH = (const bf16*)(ws + WS_WRH); const bf16* WL = (const bf16*)(ws + WS_WRL);
#pragma unroll
      for (int ks = 0; ks < 4; ++ks)
#pragma unroll
          for (int n = 0; n < 2; ++n) { const size_t o = (size_t)(n * 16 + r16) * DM + (4 * w + ks) * 32 + g4 * 8; bh[ks][n] = *(const bf16x8*)(WH + o); bl[ks][n] = *(const bf16x8*)(WL + o); } }
    f32x4 gg[4];
#pragma unroll
    for (int j = 0; j < 4; ++j) gg[j] = *((const f32x4*)g + lane + 64 * j);
    const int ntile = NTOK / 16;
    f32x4 v[2][4];
    { const int t0 = F.bid; if (t0 < ntile) {
#pragma unroll
        for (int q = 0; q < 2; ++q)
#pragma unroll
            for (int j = 0; j < 4; ++j) v[q][j] = *((const f32x4*)(H1 + (size_t)(t0 * 16 + 2 * w + q) * DM) + lane + 64 * j); } }
    for (int tl = F.bid; tl < ntile; tl += F.G) {
#pragma unroll
        for (int q = 0; q < 2; ++q) { const int rr = 2 * w + q; const int m = tl * 16 + rr; float s = 0.f;
#pragma unroll
            for (int j = 0; j < 4; ++j) s += (v[q][j].x * v[q][j].x + v[q][j].y * v[q][j].y) + (v[q][j].z * v[q][j].z + v[q][j].w * v[q][j].w);
            const float rs = frsq(wave_sum(s) * (1.f / DM) + NORM_EPS);
#pragma unroll
            for (int j = 0; j < 4; ++j) { const f32x4 y = v[q][j] * rs * gg[j];
                u32x2 h; h.x = pk2(y.x, y.y); h.y = pk2(y.z, y.w);
                u32x2 l; l.x = pk2(y.x - bflo(h.x), y.y - bfhi(h.x)); l.y = pk2(y.z - bflo(h.y), y.w - bfhi(h.y));
                *((u32x2*)(U + (size_t)m * DM) + lane + 64 * j) = h;
                *(LAS u32x2*)(HI + rr * RT_LDH + 4 * lane + 256 * j) = h; *(LAS u32x2*)(LO + rr * RT_LDH + 4 * lane + 256 * j) = l; } }
        { const int tn = tl + F.G; if (tn < ntile) {
#pragma unroll
            for (int q = 0; q < 2; ++q)
#pragma unroll
                for (int j = 0; j < 4; ++j) v[q][j] = *((const f32x4*)(H1 + (size_t)(tn * 16 + 2 * w + q) * DM) + lane + 64 * j); } }
        __syncthreads();
        { f32x4 acc[2]; acc[0] = (f32x4){0.f, 0.f, 0.f, 0.f}; acc[1] = acc[0];
#pragma unroll
          for (int ks = 0; ks < 4; ++ks) { const int ko = (4 * w + ks) * 32 + g4 * 8;
              const bf16x8 ah = *(const LAS bf16x8*)(HI + r16 * RT_LDH + ko), al = *(const LAS bf16x8*)(LO + r16 * RT_LDH + ko);
#pragma unroll
              for (int n = 0; n < 2; ++n) { acc[n] = __builtin_amdgcn_mfma_f32_16x16x32_bf16(ah, bh[ks][n], acc[n], 0, 0, 0); acc[n] = __builtin_amdgcn_mfma_f32_16x16x32_bf16(ah, bl[ks][n], acc[n], 0, 0, 0);
                  acc[n] = __builtin_amdgcn_mfma_f32_16x16x32_bf16(al, bh[ks][n], acc[n], 0, 0, 0); } }
#pragma unroll
          for (int n = 0; n < 2; ++n)
#pragma unroll
              for (int i = 0; i < 4; ++i) PART[(w * 16 + 4 * g4 + i) * 33 + n * 16 + r16] = acc[n][i]; }
        __syncthreads();
        { const int e = lane & 31, tk = 2 * w + (lane >> 5), m = tl * 16 + tk; float lg = br[e];
#pragma unroll
          for (int q = 0; q < 8; ++q) lg += PART[(q * 16 + tk) * 33 + e];
          LG[tk * 32 + e] = lg;
          LDS_WAIT(); asm volatile("" ::: "memory");
          int rank = 0; float mx = lg;
#pragma unroll
          for (int q = 0; q < 8; ++q) { const f32x4 o = *(const LAS f32x4*)(LG + tk * 32 + 4 * q);
#pragma unroll
              for (int i = 0; i < 4; ++i) { const int eo = 4 * q + i; rank += (o[i] > lg || (o[i] == lg && eo < e)) ? 1 : 0; mx = fmaxf(mx, o[i]); } }
          const float ex = __expf(lg - mx);
          if (rank < 4) EX[tk * 4 + rank] = ex;
          LDS_WAIT(); asm volatile("" ::: "memory");
          const f32x4 e4 = *(const LAS f32x4*)(EX + tk * 4);
          if (rank < 4) { const float gv = ex * frcp((e4[0] + e4[1]) + (e4[2] + e4[3]));
              const unsigned slot = __hip_atomic_fetch_add(cntw + 64 * e, 1u, RLX_AGENT);
              RT[(size_t)e * ECAP + slot] = m * 4 + rank; GW[m * 4 + rank] = gv; } }
        __syncthreads();
    }
}
__device__ __forceinline__ void p9_combine(const Frame& F, const Args& a) {
    unsigned char* ws = a.ws;
    float* H1 = (float*)(ws + WS_H1); bf16* U = (bf16*)(ws + WS_U); const bf16* YB = (const bf16*)(ws + WS_YB); const float* g = a.in[26];
    const int gw = F.bid * NWAVES + F.wave, NGW = F.G * NWAVES, lane = F.lane;
    for (int m = gw; m < NTOK; m += NGW) {
        f32x4* xr = (f32x4*)(H1 + (size_t)m * DM) + lane; const f32x4* gr = (const f32x4*)g + lane;
        f32x4 v[4]; float s = 0.f;
#pragma unroll
        for (int j = 0; j < 4; ++j) { v[j] = xr[64 * j];
#pragma unroll
            for (int k = 0; k < 4; ++k) { const u32x2 w = *((const u32x2*)(YB + ((size_t)m * 4 + k) * DM) + lane + 64 * j); v[j].x += bflo(w.x); v[j].y += bfhi(w.x); v[j].z += bflo(w.y); v[j].w += bfhi(w.y); }
            xr[64 * j] = v[j]; s += (v[j].x * v[j].x + v[j].y * v[j].y) + (v[j].z * v[j].z + v[j].w * v[j].w); }
        const float rs = frsq(wave_sum(s) * (1.f / DM) + NORM_EPS);
        unsigned long long* o8 = (unsigned long long*)(U + (size_t)m * DM) + lane;
#pragma unroll
        for (int j = 0; j < 4; ++j) { const f32x4 gg = gr[64 * j]; o8[64 * j] = (unsigned long long)pk2(v[j].x * rs * gg.x, v[j].y * rs * gg.y) | ((unsigned long long)pk2(v[j].z * rs * gg.z, v[j].w * rs * gg.w) << 32); }
    }
}
__device__ __forceinline__ void p11_final(const Frame& F, const Args& a) {
    const float* g = a.in[29];
    const int gw = F.bid * NWAVES + F.wave, NGW = F.G * NWAVES, lane = F.lane;
    for (int m = gw; m < NTOK; m += NGW) {
        f32x4* xr = (f32x4*)(a.out + (size_t)m * DM) + lane; const f32x4* gr = (const f32x4*)g + lane;
        f32x4 v[4]; float s = 0.f;
#pragma unroll
        for (int j = 0; j < 4; ++j) { v[j] = xr[64 * j]; s += (v[j].x * v[j].x + v[j].y * v[j].y) + (v[j].z * v[j].z + v[j].w * v[j].w); }
        const float rs = frsq(wave_sum(s) * (1.f / DM) + NORM_EPS);
#pragma unroll
        for (int j = 0; j < 4; ++j) { const f32x4 gg = gr[64 * j]; f32x4 y; y.x = v[j].x * rs * gg.x; y.y = v[j].y * rs * gg.y; y.z = v[j].z * rs * gg.z; y.w = v[j].w * rs * gg.w; xr[64 * j] = y; }
    }
}
__device__ __forceinline__ int moe_tables(const Frame& F, const Args& a, int NT, bool rows) {
    LAS int* pst = (LAS int*)(F.lds + MOE_TAB_OFF); LAS int* rtab = (LAS int*)(F.lds + MOE_ROWTAB_OFF);
    const int* RT = (const int*)(a.ws + WS_RT);
    if (F.tid == 0) { int acc = 0; for (int e = 0; e < NEXP; ++e) { pst[e] = acc; const int c = (int)__hip_atomic_load(F.ctl + CW_CNT + 64 * e, RLX_AGENT); pst[40 + e] = c; acc += (c + 255) >> 8; } pst[NEXP] = acc; }
    __syncthreads();
    const int npan = pst[NEXP];
    if (rows) {
        for (int i = 0; i < MAXU; ++i) { const int L = i * F.G + F.bid; if (L >= npan * NT) break;
            const int panel = L / NT; int e = 0; for (int q = 1; q < NEXP; ++q) e += (panel >= pst[q]) ? 1 : 0;
            if (F.tid < 256) { const int slot = (panel - pst[e]) * 256 + F.tid; rtab[i * 256 + F.tid] = (slot < pst[40 + e]) ? (RT[(size_t)e * ECAP + slot] >> 2) : 0; } }
    }
    __syncthreads();
    return npan;
}
constexpr int LD72 = 72, LDF = 68, LDL0 = 264;
constexpr int RW_Z = 0, RW_IA = 17408, RW_ATT = 0, RW_MABH = 9216, RW_TII = 18432;
constexpr int RW_L0 = 34816, RW_MAK = 34816, RW_MRB = 34816 + 9216, RW_MRK = 34816 + 18432;
constexpr int RW_AT = 68608, RW_RT = 77824, RW_BH = 87040, RW_KH = 96256, RW_WT = RW_BH, RW_UT = RW_KH;
constexpr int RW_BBT = 105472, RW_KBT = 114688, RW_VMT = 123904, RW_CS = 133120;
static_assert(RW_CS + 2048 <= MISC_OFF, "rwkv LDS map");
typedef short bf16x4 __attribute__((ext_vector_type(4)));
__device__ __forceinline__ bf16x4 pack4(f32x4 v) { const u32x2 t = (u32x2){pk2(v[0], v[1]), pk2(v[2], v[3])}; return __builtin_bit_cast(bf16x4, t); }
#define MFMA16(a, b, c) __builtin_amdgcn_mfma_f32_16x16x16bf16_1k(a, b, c, 0, 0, 0)

#ifndef PROBE_DUP
#define PROBE_DUP -1
#endif
#define PREP(k) _Pragma("unroll") for (int prep_ = 0; prep_ < ((PROBE_DUP == (k)) ? 2 : 1); ++prep_)
__device__ __forceinline__ void st_bf16(LAS bf16* p, float v) { *p = (bf16)f2bf(v); }

constexpr int RW_RAW = 135168, RAWLD = 200;
static_assert(RW_RAW + 65 * RAWLD * 2 <= MISC_OFF, "rwkv LDS map (raw rows)");
struct RwPref { u32x4 v[9]; };
__device__ __forceinline__ int rw_chunk_col(int cc, int h) { return cc < 8 ? C_RR + h * 64 + 8 * cc : cc < 16 ? C_RK + h * 64 + 8 * (cc - 8) : cc < 24 ? C_RV + h * 64 + 8 * (cc - 16) : C_DW + 8 * (cc - 24); }
__device__ __forceinline__ void rw_prefetch(RwPref& P, const Args& a, int unit, int tid) {
    if (tid < 448) { const int b = unit >> 10, h = (unit >> 7) & 7, c = unit & 127, cc = tid % 56, o = tid / 56;
        const bf16* p = (const bf16*)(a.ws + WS_PROJ) + (size_t)(b * SEQ + c * 64 + 8 * o - 1) * NPROJ + rw_chunk_col(cc, h);
#pragma unroll
        for (int i = 0; i < 9; ++i) { u32x4 x = (u32x4){0u, 0u, 0u, 0u}; if (i > 0 || o > 0 || c > 0) x = *(const u32x4*)(p + (size_t)i * NPROJ); P.v[i] = x; } }
}
__device__ __forceinline__ void rwkv_chunk_unit(const Frame& F, const Args& a, int unit, RwPref& P, int next_unit) {
    unsigned char* ws = a.ws; LAS unsigned char* lds = F.lds;
    const int tid = F.tid, lane = F.lane, w = F.wave;
    const int b = unit >> 10, h = (unit >> 7) & 7, c = unit & 127;
    const int rowbase = b * SEQ + c * 64;
    const float* mu = a.in[4];
    LAS bf16* L0 = (LAS bf16*)(lds + RW_L0);
    LAS float* Z = (LAS float*)(lds + RW_Z); LAS float* IA = (LAS float*)(lds + RW_IA);
    LAS bf16* ATT = (LAS bf16*)(lds + RW_ATT); LAS bf16* MABH = (LAS bf16*)(lds + RW_MABH); LAS bf16* TII = (LAS bf16*)(lds + RW_TII);
    LAS bf16* MAK = (LAS bf16*)(lds + RW_MAK); LAS bf16* MRB = (LAS bf16*)(lds + RW_MRB); LAS bf16* MRK = (LAS bf16*)(lds + RW_MRK);
    LAS bf16* AT_ = (LAS bf16*)(lds + RW_AT); LAS bf16* RT_ = (LAS bf16*)(lds + RW_RT); LAS bf16* BH_ = (LAS bf16*)(lds + RW_BH); LAS bf16* KH_ = (LAS bf16*)(lds + RW_KH);
    LAS bf16* WT = (LAS bf16*)(lds + RW_WT); LAS bf16* UT = (LAS bf16*)(lds + RW_UT);
    LAS bf16* BBT = (LAS bf16*)(lds + RW_BBT); LAS bf16* KBT = (LAS bf16*)(lds + RW_KBT); LAS bf16* VMT = (LAS bf16*)(lds + RW_VMT);
    LAS float* CS = (LAS float*)(lds + RW_CS); LAS bf16* RAW = (LAS bf16*)(lds + RW_RAW);
    const int r16 = lane & 15, g4 = lane >> 4;

    if (tid < 448) {
        const int cc = tid % 56, o = tid / 56;
        if (cc < 24) {
            const int co = (cc >> 3) * 64 + (cc & 7) * 8;
            if (o == 0) *(LAS u32x4*)(RAW + co) = P.v[0];
#pragma unroll
            for (int i = 1; i < 9; ++i) *(LAS u32x4*)(RAW + (8 * o + i) * RAWLD + co) = P.v[i];
        } else {
            const int lc = (cc - 24) * 8;
            const f32x4 m0 = *(const f32x4*)(mu + C_DW + lc), m1 = *(const f32x4*)(mu + C_DW + lc + 4);
            const float sc = lc < 64 ? 2.f : 1.f;
#pragma unroll
            for (int i = 1; i < 9; ++i) { const u32x4 xc = P.v[i], xp = P.v[i - 1];
                const unsigned cw[4] = {xc.x, xc.y, xc.z, xc.w}, pw[4] = {xp.x, xp.y, xp.z, xp.w}; float hv[8];
#pragma unroll
                for (int j = 0; j < 4; ++j) { const float x0 = bflo(cw[j]), x1 = bfhi(cw[j]), p0 = bflo(pw[j]), p1 = bfhi(pw[j]);
                    const float ma = (j < 2) ? m0[2 * j] : m1[2 * j - 4], mb = (j < 2) ? m0[2 * j + 1] : m1[2 * j - 3];
                    hv[2 * j] = x0 + (p0 - x0) * ma; hv[2 * j + 1] = x1 + (p1 - x1) * mb; }
#pragma unroll
                for (int j = 0; j < 8; ++j) { const float y = sigmoidf_(hv[j] * sc); hv[j] = lc < 64 ? (2.f * y - 1.f) : (lc < 128 ? hv[j] : y); }
                u32x4 ov; ov.x = pk2(hv[0], hv[1]); ov.y = pk2(hv[2], hv[3]); ov.z = pk2(hv[4], hv[5]); ov.w = pk2(hv[6], hv[7]);
                *(LAS u32x4*)(L0 + (8 * o + i - 1) * LDL0 + lc) = ov; }
        }
    }
    __syncthreads();
    {
        const bf16* W2T = (const bf16*)(ws + WS_LW2T) + (size_t)h * 64 * 64; const bf16* A2T = (const bf16*)(ws + WS_LA2T) + (size_t)h * 64 * 64; const bf16* G2T = (const bf16*)(ws + WS_LG2T) + (size_t)h * 64 * 128;
        bf16* GATEB = (bf16*)(ws + WS_GATEB);
        f32x4 az[2], ai[2], ag[2];
#pragma unroll
        for (int q = 0; q < 2; ++q) { const int tt = 2 * w + q, m0 = (tt >> 2) * 16, n0 = (tt & 3) * 16; const f32x4 zz = (f32x4){0.f, 0.f, 0.f, 0.f};
            az[q] = mm_lg<2, true>(L0 + m0 * LDL0, LDL0, W2T + n0 * 64, 64, lane, zz);
            ai[q] = mm_lg<2, true>(L0 + m0 * LDL0 + 64, LDL0, A2T + n0 * 64, 64, lane, zz);
            ag[q] = mm_lg<4, true>(L0 + m0 * LDL0 + 128, LDL0, G2T + n0 * 128, 128, lane, zz); }
#pragma unroll
        for (int q = 0; q < 2; ++q) { const int tt = 2 * w + q, m0 = (tt >> 2) * 16, n0 = (tt & 3) * 16;
            *(LAS f32x4*)(Z + (m0 + r16) * LDF + n0 + 4 * g4) = az[q]; *(LAS f32x4*)(IA + (m0 + r16) * LDF + n0 + 4 * g4) = ai[q];
            u32x2 ov; ov.x = pk2(ag[q][0], ag[q][1]); ov.y = pk2(ag[q][2], ag[q][3]); *(u32x2*)(GATEB + (size_t)(rowbase + m0 + r16) * 512 + h * 64 + n0 + 4 * g4) = ov; }
    }
    __syncthreads();
    {
        const int d = lane, hd = h * 64 + d;
        const float mur = mu[C_RR + hd], muk = mu[C_RK + hd], muv = mu[C_RV + hd];
        const float w0 = a.in[5][hd], a0 = a.in[7][hd], kkw = a.in[10][hd], kaw = a.in[11][hd], rkw = a.in[12][hd];
        float rv[8], kv[8], vv[8], lw[8], av[8], kk[8], km[8];
        { const LAS bf16* p0 = RAW + (8 * w) * RAWLD + d;
          float pr = bf2f(p0[0]), pk = bf2f(p0[64]), pv = bf2f(p0[128]);
#pragma unroll
          for (int i = 0; i < 8; ++i) { const LAS bf16* p = p0 + (i + 1) * RAWLD; const float xr = bf2f(p[0]), xk = bf2f(p[64]), xv = bf2f(p[128]);
              rv[i] = xr + (pr - xr) * mur; kv[i] = xk + (pk - xk) * muk; vv[i] = xv + (pv - xv) * muv; pr = xr; pk = xk; pv = xv; } }
        bf16* BONUSB = (bf16*)(ws + WS_BONUSB);
        float run = 0.f;
#pragma unroll
        for (int i = 0; i < 8; ++i) { const int t = 8 * w + i;
            const float z = Z[t * LDF + d] + w0; const float sp = __logf(1.f + __expf(-z)); const float wlog = -sp - 0.5f; lw[i] = -__expf(wlog);
            av[i] = sigmoidf_(IA[t * LDF + d] + a0);
            const float kr = kv[i] * kkw; const float n2 = wave_sum(kr * kr); kk[i] = kr * frsq(fmaxf(n2, 1e-24f));
            km[i] = kv[i] * (1.f + (av[i] - 1.f) * kaw);
            const float bs = wave_sum(rv[i] * km[i] * rkw);
            BONUSB[(size_t)(rowbase + t) * 512 + hd] = (bf16)f2bf(bs * vv[i]);
            run += lw[i]; lw[i] = run;
        }
        CS[w * 64 + d] = run;
        __syncthreads();
        float off = 0.f, tot = 0.f;
#pragma unroll
        for (int q = 0; q < 8; ++q) { const float s = CS[q * 64 + d]; tot += s; off += (q < w) ? s : 0.f; }
        if (w == 0) ((float*)(ws + WS_DV))[(size_t)unit * 64 + d] = __expf(tot);
        unsigned pb[4], pkk[4], pvv[4], pat[4];
        float prevc = off;
#pragma unroll
        for (int i = 0; i < 8; ++i) { const int t = 8 * w + i;
            const float ct = off + lw[i];
            const float ec = __expf(ct), ecp = __expf(prevc), en = __expf(-ct), er = __expf(tot - ct);
            prevc = ct;
            const float be = kk[i] * av[i];
            const unsigned xa = f2bf(-kk[i] * ecp); AT_[t * LD72 + d] = (bf16)xa; st_bf16(RT_ + t * LD72 + d, rv[i] * ec);
            st_bf16(BH_ + t * LD72 + d, be * en); st_bf16(KH_ + t * LD72 + d, km[i] * en);
            const unsigned xb = f2bf(be * er), xk = f2bf(km[i] * er), xv = f2bf(vv[i]);
            if (i & 1) { pb[i >> 1] |= xb << 16; pkk[i >> 1] |= xk << 16; pvv[i >> 1] |= xv << 16; pat[i >> 1] |= xa << 16; } else { pb[i >> 1] = xb; pkk[i >> 1] = xk; pvv[i >> 1] = xv; pat[i >> 1] = xa; }
        }
        *(LAS u32x4*)(ATT + d * LD72 + 8 * w) = (u32x4){pat[0], pat[1], pat[2], pat[3]};
        *(LAS u32x4*)(BBT + d * LD72 + 8 * w) = (u32x4){pb[0], pb[1], pb[2], pb[3]};
        *(LAS u32x4*)(KBT + d * LD72 + 8 * w) = (u32x4){pkk[0], pkk[1], pkk[2], pkk[3]};
        *(LAS u32x4*)(VMT + d * LD72 + 8 * w) = (u32x4){pvv[0], pvv[1], pvv[2], pvv[3]};
    }
    __syncthreads();
    if (next_unit >= 0) rw_prefetch(P, a, next_unit, tid);
    PREP(23) {
    {
        const int mi = w >> 1;
        const LAS bf16* Am = (mi < 2) ? AT_ : RT_; const LAS bf16* Bm = (mi & 1) ? KH_ : BH_;
        LAS bf16* Om = (mi == 0) ? MABH : (mi == 1) ? MAK : (mi == 2 ? MRB : MRK);
        for (int q = 0; q < 8; ++q) { const int tt = (w & 1) * 8 + q, mt = tt >> 2, ntl = tt & 3, m0 = mt * 16, n0 = ntl * 16;
            f32x4 acc = (f32x4){0.f, 0.f, 0.f, 0.f};
            if (ntl <= mt) acc = mm_ll<2, true>(Am + m0 * LD72, LD72, Bm + n0 * LD72, LD72, lane, acc);
            const int trow = m0 + r16;
#pragma unroll
            for (int i = 0; i < 4; ++i) { const int j = n0 + 4 * g4 + i; const bool keep = (mi < 2) ? (j < trow) : (j <= trow); acc[i] = keep ? acc[i] : 0.f; }
            u32x2 o; o.x = pk2(acc[0], acc[1]); o.y = pk2(acc[2], acc[3]); *(LAS u32x2*)(Om + trow * LD72 + n0 + 4 * g4) = o;
        }
        if (w < 4) {
            const int i0 = 16 * w;
            f32x4 nA = (f32x4){0.f, 0.f, 0.f, 0.f}, nB = nA;
            nA = mm_ll<2, true>(AT_ + i0 * LD72, LD72, BH_ + i0 * LD72, LD72, lane, nA);
            nB = mm_ll<2, false>(AT_ + i0 * LD72, LD72, BH_ + i0 * LD72, LD72, lane, nB);
            f32x4 PA, PB;
#pragma unroll
            for (int j = 0; j < 4; ++j) { const int cc = 4 * g4 + j; nA[j] = (cc < r16) ? nA[j] : 0.f; nB[j] = (r16 < cc) ? nB[j] : 0.f; const float id = (cc == r16) ? 1.f : 0.f; PA[j] = nA[j] + id; PB[j] = nB[j] + id; }
            bf16x4 pNA = pack4(nA), pNB = pack4(nB);
            const f32x4 zz = (f32x4){0.f, 0.f, 0.f, 0.f};
#pragma unroll
            for (int st = 0; st < 3; ++st) {
                const f32x4 n2B = MFMA16(pNA, pNB, zz), n2A = MFMA16(pNB, pNA, zz);
                const bf16x4 pN2A = pack4(n2A), pN2B = pack4(n2B), pPA = pack4(PA);
                PB = MFMA16(pPA, pN2B, PB); PA = MFMA16(pN2B, pPA, PA);
                pNA = pN2A; pNB = pN2B; }
            *(LAS bf16x4*)(TII + (w * 16 + r16) * 16 + 4 * g4) = pack4(PA);
        }
    }
    __syncthreads();
    }
    PREP(25) {
    {
        const int cb = w & 3; const bool isw = w < 4;
        f32x4 rhs[4];
        if (isw) {
#pragma unroll
            for (int i = 0; i < 4; ++i) { const u32x2 t = *(const LAS u32x2*)(ATT + (16 * cb + r16) * LD72 + 16 * i + 4 * g4); rhs[i] = (f32x4){bflo(t.x), bfhi(t.x), bflo(t.y), bfhi(t.y)}; }
        } else {
#pragma unroll
            for (int i = 0; i < 4; ++i) { rhs[i] = (f32x4){0.f, 0.f, 0.f, 0.f}; rhs[i] = mm_ll<2, false>(MAK + (16 * i) * LD72, LD72, VMT + (16 * cb) * LD72, LD72, lane, rhs[i]); }
        }
        LAS bf16* O = isw ? WT : UT;
        bf16x4 px[4];
        const f32x4 zz = (f32x4){0.f, 0.f, 0.f, 0.f};
#pragma unroll
        for (int i = 0; i < 4; ++i) { f32x4 y = rhs[i];
#pragma unroll
            for (int j = 0; j < 4; ++j) if (j < i) { const bf16x4 am = *(const LAS bf16x4*)(MABH + (16 * i + r16) * LD72 + 16 * j + 4 * g4); y = MFMA16(am, px[j], y); }
            const bf16x4 tt = *(const LAS bf16x4*)(TII + (i * 16 + r16) * 16 + 4 * g4);
            const f32x4 x = MFMA16(tt, pack4(y), zz);
            px[i] = pack4(x);
            *(LAS bf16x4*)(O + (16 * cb + r16) * LD72 + 16 * i + 4 * g4) = px[i]; }
    }
    __syncthreads();
    }
    PREP(26) {
    {
        const int mt = w >> 1, m0 = mt * 16, sh = w & 1;
        { f32x4 c0 = (f32x4){0.f, 0.f, 0.f, 0.f}, c1 = c0;
          c0 = mm_ll<2, true>(BBT + m0 * LD72, LD72, WT + (32 * sh) * LD72, LD72, lane, c0);
          c1 = mm_ll<2, true>(BBT + m0 * LD72, LD72, WT + (32 * sh + 16) * LD72, LD72, lane, c1);
          u32x4 o; o.x = pk2(c0[0], c0[1]); o.y = pk2(c0[2], c0[3]); o.z = pk2(c1[0], c1[1]); o.w = pk2(c1[2], c1[3]);
          *((u32x4*)(ws + WS_PLT) + ((size_t)unit * 8 + mt * 2 + sh) * 64 + lane) = o; }
#pragma unroll
        for (int q = 0; q < 2; ++q) { const int vq = 2 * sh + q; f32x4 acc = (f32x4){0.f, 0.f, 0.f, 0.f};
            acc = mm_ll<2, false>(BBT + m0 * LD72, LD72, UT + (vq * 16) * LD72, LD72, lane, acc);
            acc = mm_ll<2, false>(KBT + m0 * LD72, LD72, VMT + (vq * 16) * LD72, LD72, lane, acc);
            *((f32x4*)(ws + WS_QT) + (((size_t)unit * 4 + vq) * 4 + mt) * 64 + lane) = acc; }
#pragma unroll
        for (int q = 0; q < 2; ++q) { const int n0 = (2 * sh + q) * 16; f32x4 acc = (f32x4){0.f, 0.f, 0.f, 0.f};
            acc = mm_ll<2, true>(MRB + m0 * LD72, LD72, WT + n0 * LD72, LD72, lane, acc);
            const u32x2 rr = *(const LAS u32x2*)(RT_ + (m0 + r16) * LD72 + n0 + 4 * g4);
            u32x2 o; o.x = pk2(acc[0] + bflo(rr.x), acc[1] + bfhi(rr.x)); o.y = pk2(acc[2] + bflo(rr.y), acc[3] + bfhi(rr.y));
            *(u32x2*)((bf16*)(ws + WS_GB) + (size_t)unit * 4096 + (m0 + r16) * 64 + n0 + 4 * g4) = o;
            f32x4 ol = (f32x4){0.f, 0.f, 0.f, 0.f};
            ol = mm_ll<2, true>(MRB + m0 * LD72, LD72, UT + n0 * LD72, LD72, lane, ol);
            ol = mm_ll<2, true>(MRK + m0 * LD72, LD72, VMT + n0 * LD72, LD72, lane, ol);
            *(f32x4*)((float*)(ws + WS_OL) + (size_t)unit * 4096 + (m0 + r16) * 64 + n0 + 4 * g4) = ol; }
    }
    __syncthreads();
    }
}

constexpr int GL_KBT = 0, GL_VT = 9216, GL_CS = 9216 + 18432;
constexpr int GL_QT = 32768, GL_KH = GL_QT + 9216, GL_ATT = GL_KH + 9216, GL_SS = GL_ATT + 9216;
constexpr int GL_KR = 65536, GL_VR = GL_KR + 9216, GL_DGR = GL_VR + 64 * 136 * 2, GL_QR = GL_DGR + 64 * 24 * 2, GL_GR = GL_QR + 9216;
static_assert(GL_GR + 64 * 136 * 2 <= MISC_OFF, "gla LDS map");
template <int NCC> struct GlPref { u32x4 v[8]; };
template <int NCC> __device__ __forceinline__ int gl_chunk_col(int cc, int h) {
    return cc < 8 ? C_GK + h * 64 + 8 * cc : cc < 24 ? C_GV + h * 128 + 8 * (cc - 8) : cc < 26 ? C_GD + 8 * (cc - 24) : cc < 34 ? C_GQ + h * 64 + 8 * (cc - 26) : C_GG + h * 128 + 8 * (cc - 34); }
template <int NCC> __device__ __forceinline__ void gl_prefetch(GlPref<NCC>& P, const Args& a, int unit, int tid) {
    if (tid < NCC * 8) { const int b = unit >> 9, h = (unit >> 7) & 3, c = unit & 127, cc = tid % NCC, o = tid / NCC;
        const bf16* p = (const bf16*)(a.ws + WS_PROJ) + (size_t)(b * SEQ + c * 64 + 8 * o) * NPROJ + gl_chunk_col<NCC>(cc, h);
#pragma unroll
        for (int i = 0; i < 8; ++i) P.v[i] = *(const u32x4*)(p + (size_t)i * NPROJ); }
}
template <int NCC> __device__ __forceinline__ void gl_park(const GlPref<NCC>& P, LAS unsigned char* lds, int tid) {
    if (tid < NCC * 8) { const int cc = tid % NCC, o = tid / NCC;
        LAS bf16* dst; int ld;
        if (cc < 8) { dst = (LAS bf16*)(lds + GL_KR) + 8 * cc; ld = 72; } else if (cc < 24) { dst = (LAS bf16*)(lds + GL_VR) + 8 * (cc - 8); ld = 136; } else if (cc < 26) { dst = (LAS bf16*)(lds + GL_DGR) + 8 * (cc - 24); ld = 24; }
        else if (cc < 34) { dst = (LAS bf16*)(lds + GL_QR) + 8 * (cc - 26); ld = 72; } else { dst = (LAS bf16*)(lds + GL_GR) + 8 * (cc - 34); ld = 136; }
#pragma unroll
        for (int i = 0; i < 8; ++i) *(LAS u32x4*)(dst + (8 * o + i) * ld) = P.v[i]; }
}
__device__ __forceinline__ void gla_loga_octet(const Args& a, LAS unsigned char* lds, int h, int w, int d, float (&cl)[8]) {
    const float* gk2 = a.in[15]; const float gb = a.in[16][h * 64 + d];
    float wk[16];
#pragma unroll
    for (int j = 0; j < 16; ++j) wk[j] = gk2[j * 256 + h * 64 + d];
    const LAS bf16* DGR = (const LAS bf16*)(lds + GL_DGR);
    float run = 0.f;
#pragma unroll
    for (int i = 0; i < 8; ++i) { const u32x4 d0 = *(const LAS u32x4*)(DGR + (8 * w + i) * 24), d1 = *(const LAS u32x4*)(DGR + (8 * w + i) * 24 + 8);
        const unsigned dw[8] = {d0.x, d0.y, d0.z, d0.w, d1.x, d1.y, d1.z, d1.w};
        float s = gb;
#pragma unroll
        for (int j = 0; j < 8; ++j) { s += bflo(dw[j]) * wk[2 * j]; s += bfhi(dw[j]) * wk[2 * j + 1]; }
        const float ls = fminf(s, 0.f) - __logf(1.f + __expf(-fabsf(s)));
        run += ls * (1.f / 16.f); cl[i] = run; }
}

__device__ __forceinline__ void gla_chunk_unit(const Frame& F, const Args& a, int unit, GlPref<26>& P, int next_unit) {
    unsigned char* ws = a.ws; LAS unsigned char* lds = F.lds;
    const int lane = F.lane, w = F.wave;
    const int h = (unit >> 7) & 3;
    LAS bf16* KBT = (LAS bf16*)(lds + GL_KBT); LAS bf16* VT = (LAS bf16*)(lds + GL_VT); LAS float* CS = (LAS float*)(lds + GL_CS);
    const LAS bf16* KR = (const LAS bf16*)(lds + GL_KR); const LAS bf16* VR = (const LAS bf16*)(lds + GL_VR);
    const int r16 = lane & 15, g4 = lane >> 4;
    gl_park<26>(P, lds, F.tid);
    __syncthreads();
    {
        const int d = lane; float cl[8];
        gla_loga_octet(a, lds, h, w, d, cl);
        CS[w * 64 + d] = cl[7];
        __syncthreads();
        float off = 0.f, tot = 0.f;
#pragma unroll
        for (int q = 0; q < 8; ++q) { const float s = CS[q * 64 + d]; tot += s; off += (q < w) ? s : 0.f; }
        if (w == 0) ((float*)(ws + WS_GDEC))[(size_t)unit * 64 + d] = __expf(tot);
        unsigned pk_[4], pv0[4], pv1[4];
#pragma unroll
        for (int i = 0; i < 8; ++i) { const int t = 8 * w + i;
            const float kx = bf2f(KR[t * 72 + d]); const unsigned xk = f2bf(kx * __expf(tot - (off + cl[i])));
            const unsigned v0 = VR[t * 136 + d], v1 = VR[t * 136 + 64 + d];
            if (i & 1) { pk_[i >> 1] |= xk << 16; pv0[i >> 1] |= v0 << 16; pv1[i >> 1] |= v1 << 16; } else { pk_[i >> 1] = xk; pv0[i >> 1] = v0; pv1[i >> 1] = v1; } }
        *(LAS u32x4*)(KBT + d * LD72 + 8 * w) = (u32x4){pk_[0], pk_[1], pk_[2], pk_[3]};
        *(LAS u32x4*)(VT + d * LD72 + 8 * w) = (u32x4){pv0[0], pv0[1], pv0[2], pv0[3]};
        *(LAS u32x4*)(VT + (64 + d) * LD72 + 8 * w) = (u32x4){pv1[0], pv1[1], pv1[2], pv1[3]};
    }
    __syncthreads();
    if (next_unit >= 0) gl_prefetch<26>(P, a, next_unit, F.tid);
    {
        float* LS = (float*)(ws + WS_LS) + (size_t)unit * 8192;
#pragma unroll
        for (int q = 0; q < 4; ++q) { f32x4 acc = (f32x4){0.f, 0.f, 0.f, 0.f};
            acc = mm_ll<2, true>(VT + (w * 16) * LD72, LD72, KBT + (q * 16) * LD72, LD72, lane, acc);
            *(f32x4*)(LS + (w * 16 + r16) * 64 + q * 16 + 4 * g4) = acc; }
    }
    __syncthreads();
}

constexpr int SC_B = 6, SC_SLOT = 8192 + 4096 + 256, SC_BUF = SC_B * SC_SLOT, SC_NB = (NCH + SC_B - 1) / SC_B;
static_assert(2 * SC_BUF <= MISC_OFF, "scan LDS");
struct ScanRegs { u32x4 p[8]; f32x4 q[4]; float d; };
__device__ __forceinline__ void scan_fetch(ScanRegs& R, const Args& a, int bh, int vq, int step, int lane) {
    const size_t unit = (size_t)bh * NCH + (step < NCH ? step : NCH - 1);
    const u32x4* PLT = (const u32x4*)(a.ws + WS_PLT); const f32x4* QT = (const f32x4*)(a.ws + WS_QT); const float* DV = (const float*)(a.ws + WS_DV);
#pragma unroll
    for (int i = 0; i < 8; ++i) R.p[i] = PLT[(unit * 8 + i) * 64 + lane];
#pragma unroll
    for (int m = 0; m < 4; ++m) R.q[m] = QT[((unit * 4 + vq) * 4 + m) * 64 + lane];
    R.d = DV[unit * 64 + lane];
}
__device__ __forceinline__ void scan_park(const ScanRegs& R, LAS unsigned char* slot, int lane) {
#pragma unroll
    for (int i = 0; i < 8; ++i) *(LAS u32x4*)(slot + i * 1024 + lane * 16) = R.p[i];
#pragma unroll
    for (int m = 0; m < 4; ++m) *(LAS f32x4*)(slot + 8192 + m * 1024 + lane * 16) = R.q[m];
    *(LAS float*)(slot + 12288 + lane * 4) = R.d;
}
__device__ __forceinline__ void scan_steps(f32x4 (&acc)[4], const Args& a, LAS unsigned char* buf, int bh, int vq, int step0, int lane) {
    const int r16 = lane & 15, g4 = lane >> 4;
    bf16* S0 = (bf16*)(a.ws + WS_S0);
#pragma unroll 1
    for (int s = 0; s < SC_B; ++s) { const int step = step0 + s; if (step >= NCH) break;
        const size_t unit = (size_t)bh * NCH + step; LAS unsigned char* slot = buf + s * SC_SLOT;
        u32x2 pkd[4];
#pragma unroll
        for (int m = 0; m < 4; ++m) { pkd[m].x = pk2(acc[m][0], acc[m][1]); pkd[m].y = pk2(acc[m][2], acc[m][3]);
            *(u32x2*)(S0 + unit * 4096 + (size_t)(vq * 16 + r16) * 64 + 16 * m + 4 * g4) = pkd[m]; }
        bf16x8 bfr[2];
#pragma unroll
        for (int k = 0; k < 2; ++k) { const u32x4 t = (u32x4){pkd[2 * k].x, pkd[2 * k].y, pkd[2 * k + 1].x, pkd[2 * k + 1].y}; bfr[k] = __builtin_bit_cast(bf16x8, t); }
#pragma unroll
        for (int m = 0; m < 4; ++m) { const f32x4 dv = *(const LAS f32x4*)(slot + 12288 + (16 * m + 4 * g4) * 4), qv = *(const LAS f32x4*)(slot + 8192 + m * 1024 + lane * 16);
            const bf16x8 a0 = *(const LAS bf16x8*)(slot + (m * 2) * 1024 + lane * 16), a1 = *(const LAS bf16x8*)(slot + (m * 2 + 1) * 1024 + lane * 16);
            f32x4 n = acc[m] * dv + qv;
            n = __builtin_amdgcn_mfma_f32_16x16x32_bf16(a0, bfr[0], n, 0, 0, 0);
            n = __builtin_amdgcn_mfma_f32_16x16x32_bf16(a1, bfr[1], n, 0, 0, 0);
            acc[m] = n; }
    }
}
__device__ __forceinline__ void rwkv_scan_wg(const Frame& F, const Args& a, int chain) {
    const int bh = chain >> 2, vq = chain & 3, w = F.wave, lane = F.lane;
    LAS unsigned char* buf0 = F.lds; LAS unsigned char* buf1 = F.lds + SC_BUF;
    const bool loader = (w >= 1 && w <= SC_B);
    ScanRegs RA, RB;
    f32x4 acc[4];
#pragma unroll
    for (int m = 0; m < 4; ++m) acc[m] = (f32x4){0.f, 0.f, 0.f, 0.f};
    if (loader) { scan_fetch(RA, a, bh, vq, w - 1, lane); scan_fetch(RB, a, bh, vq, SC_B + w - 1, lane);
        scan_park(RA, buf0 + (w - 1) * SC_SLOT, lane); scan_fetch(RA, a, bh, vq, 2 * SC_B + w - 1, lane); }
    __syncthreads();
#pragma unroll 1
    for (int b = 0; b < SC_NB; b += 2) {
        if (w == 0) scan_steps(acc, a, buf0, bh, vq, b * SC_B, lane);
        if (loader) { scan_park(RB, buf1 + (w - 1) * SC_SLOT, lane); scan_fetch(RB, a, bh, vq, (b + 3) * SC_B + w - 1, lane); }
        __syncthreads();
        if (w == 0) scan_steps(acc, a, buf1, bh, vq, (b + 1) * SC_B, lane);
        if (loader) { scan_park(RA, buf0 + (w - 1) * SC_SLOT, lane); scan_fetch(RA, a, bh, vq, (b + 4) * SC_B + w - 1, lane); }
        __syncthreads();
    }
}
__device__ __forceinline__ void gla_scan_thread(const Args& a, int idx) {
    unsigned char* ws = a.ws;
    const int bh = idx >> 13, e = idx & 8191;
    const float* LS = (const float*)(ws + WS_LS); const float* GD = (const float*)(ws + WS_GDEC); bf16* SG = (bf16*)(ws + WS_SG);
    float st = 0.f;
#pragma unroll 16
    for (int c = 0; c < NCH; ++c) { const size_t unit = (size_t)bh * NCH + c;
        const float ls = LS[unit * 8192 + e]; const float gd = GD[unit * 64 + (e & 63)];
        SG[unit * 8192 + e] = (bf16)f2bf(st);
        st = st * gd + ls; }
}

__device__ __forceinline__ void rwkv_out_wave(const Args& a, int unit, int lane) {
    unsigned char* ws = a.ws;
    const int b = unit >> 10, h = (unit >> 7) & 7, c = unit & 127; const int rowbase = b * SEQ + c * 64;
    const int r16 = lane & 15, g4 = lane >> 4;
    const bf16* GB = (const bf16*)(ws + WS_GB) + (size_t)unit * 4096; const bf16* S0 = (const bf16*)(ws + WS_S0) + (size_t)unit * 4096; const float* OL = (const float*)(ws + WS_OL) + (size_t)unit * 4096;
    const bf16* GATEB = (const bf16*)(ws + WS_GATEB); const bf16* BONUSB = (const bf16*)(ws + WS_BONUSB); bf16* YM = (bf16*)(ws + WS_YMIX);
    const float* gnw = a.in[13] + h * 64; const float* gnb = a.in[14] + h * 64;
    for (int mt = 0; mt < 4; ++mt) { const int m0 = mt * 16; const int t = m0 + r16;
        f32x4 o[4]; float s = 0.f;
#pragma unroll
        for (int nt = 0; nt < 4; ++nt) { f32x4 acc = *(const f32x4*)(OL + t * 64 + nt * 16 + 4 * g4);
            acc = mm_gg<2, true>(GB + m0 * 64, 64, S0 + (nt * 16) * 64, 64, lane, acc); o[nt] = acc; s += (acc[0] + acc[1]) + (acc[2] + acc[3]); }
        s += __shfl_xor(s, 16); s += __shfl_xor(s, 32);
        const float mean = s * (1.f / 64.f); float q = 0.f;
#pragma unroll
        for (int nt = 0; nt < 4; ++nt) { const f32x4 dd = o[nt] - mean; q += (dd[0] * dd[0] + dd[1] * dd[1]) + (dd[2] * dd[2] + dd[3] * dd[3]); }
        q += __shfl_xor(q, 16); q += __shfl_xor(q, 32);
        const float rstd = frsq(q * (1.f / 64.f) + GN_EPS);
        const size_t ro = (size_t)(rowbase + t) * 512 + h * 64;
#pragma unroll
        for (int nt = 0; nt < 4; ++nt) { const int v0 = nt * 16 + 4 * g4;
            const f32x4 gw_ = *(const f32x4*)(gnw + v0), gb_ = *(const f32x4*)(gnb + v0);
            const u32x2 gt = *(const u32x2*)(GATEB + ro + v0), bn = *(const u32x2*)(BONUSB + ro + v0);
            const float y0 = ((o[nt][0] - mean) * rstd * gw_[0] + gb_[0] + bflo(bn.x)) * bflo(gt.x), y1 = ((o[nt][1] - mean) * rstd * gw_[1] + gb_[1] + bfhi(bn.x)) * bfhi(gt.x);
            const float y2 = ((o[nt][2] - mean) * rstd * gw_[2] + gb_[2] + bflo(bn.y)) * bflo(gt.y), y3 = ((o[nt][3] - mean) * rstd * gw_[3] + gb_[3] + bfhi(bn.y)) * bfhi(gt.y);
            u32x2 w; w.x = pk2(y0, y1); w.y = pk2(y2, y3);
            *(u32x2*)(YM + (size_t)(rowbase + t) * DM + h * 64 + v0) = w; }
    }
}
__device__ __forceinline__ void gla_out_unit(const Frame& F, const Args& a, int unit, GlPref<50>& P, int next_unit) {
    unsigned char* ws = a.ws; LAS unsigned char* lds = F.lds;
    const int lane = F.lane, w = F.wave;
    const int b = unit >> 9, h = (unit >> 7) & 3, c = unit & 127;
    const int rowbase = b * SEQ + c * 64;
    LAS bf16* VT = (LAS bf16*)(lds + GL_VT); LAS float* CS = (LAS float*)(lds + GL_CS);
    LAS bf16* QT_ = (LAS bf16*)(lds + GL_QT); LAS bf16* KH_ = (LAS bf16*)(lds + GL_KH); LAS bf16* ATT = (LAS bf16*)(lds + GL_ATT); LAS float* SS = (LAS float*)(lds + GL_SS);
    const LAS bf16* KR = (const LAS bf16*)(lds + GL_KR); const LAS bf16* VR = (const LAS bf16*)(lds + GL_VR); const LAS bf16* QR = (const LAS bf16*)(lds + GL_QR); const LAS bf16* GR = (const LAS bf16*)(lds + GL_GR);
    const int r16 = lane & 15, g4 = lane >> 4;
    gl_park<50>(P, lds, F.tid);
    __syncthreads();
    {
        const int d = lane; float cl[8];
        gla_loga_octet(a, lds, h, w, d, cl);
        CS[w * 64 + d] = cl[7];
        __syncthreads();
        float off = 0.f;
#pragma unroll
        for (int q = 0; q < 8; ++q) { const float s = CS[q * 64 + d]; off += (q < w) ? s : 0.f; }
        unsigned pv0[4], pv1[4];
#pragma unroll
        for (int i = 0; i < 8; ++i) { const int t = 8 * w + i;
            const float bt = off + cl[i];
            const float qx = bf2f(QR[t * 72 + d]) * 0.125f, kx = bf2f(KR[t * 72 + d]);
            st_bf16(QT_ + t * LD72 + d, qx * __expf(bt)); st_bf16(KH_ + t * LD72 + d, kx * __expf(-bt));
            const unsigned v0 = VR[t * 136 + d], v1 = VR[t * 136 + 64 + d];
            if (i & 1) { pv0[i >> 1] |= v0 << 16; pv1[i >> 1] |= v1 << 16; } else { pv0[i >> 1] = v0; pv1[i >> 1] = v1; } }
        *(LAS u32x4*)(VT + d * LD72 + 8 * w) = (u32x4){pv0[0], pv0[1], pv0[2], pv0[3]};
        *(LAS u32x4*)(VT + (64 + d) * LD72 + 8 * w) = (u32x4){pv1[0], pv1[1], pv1[2], pv1[3]};
    }
    __syncthreads();
    if (next_unit >= 0) gl_prefetch<50>(P, a, next_unit, F.tid);
    {
#pragma unroll
        for (int q = 0; q < 2; ++q) { const int T = 2 * w + q, mt = T >> 2, ntl = T & 3, m0 = mt * 16, n0 = ntl * 16;
            f32x4 acc = (f32x4){0.f, 0.f, 0.f, 0.f};
            if (ntl <= mt) acc = mm_ll<2, true>(QT_ + m0 * LD72, LD72, KH_ + n0 * LD72, LD72, lane, acc);
#pragma unroll
            for (int i = 0; i < 4; ++i) acc[i] = (n0 + 4 * g4 + i <= m0 + r16) ? acc[i] : 0.f;
            u32x2 o; o.x = pk2(acc[0], acc[1]); o.y = pk2(acc[2], acc[3]); *(LAS u32x2*)(ATT + (m0 + r16) * LD72 + n0 + 4 * g4) = o; }
    }
    __syncthreads();
    {
        const int mt = w >> 1, m0 = mt * 16, nh = w & 1; const int t = m0 + r16;
        const bf16* SG = (const bf16*)(ws + WS_SG) + (size_t)unit * 8192;
        f32x4 o[4]; float s = 0.f;
#pragma unroll
        for (int q = 0; q < 4; ++q) { const int n0 = (4 * nh + q) * 16; f32x4 acc = (f32x4){0.f, 0.f, 0.f, 0.f};
            acc = mm_lg<2, true>(QT_ + m0 * LD72, LD72, SG + (size_t)n0 * 64, 64, lane, acc);
            acc = mm_ll<2, true>(ATT + m0 * LD72, LD72, VT + n0 * LD72, LD72, lane, acc);
            o[q] = acc; s += (acc[0] * acc[0] + acc[1] * acc[1]) + (acc[2] * acc[2] + acc[3] * acc[3]); }
        s += __shfl_xor(s, 16); s += __shfl_xor(s, 32);
        if (g4 == 0) SS[t * 2 + nh] = s;
        __syncthreads();
        const float ms = (SS[t * 2] + SS[t * 2 + 1]) * (1.f / 128.f); const float rs = frsq(ms + NORM_EPS);
        const float* ng = a.in[17] + h * 128; bf16* YM = (bf16*)(ws + WS_YMIX);
        const LAS bf16* prow = GR + t * 136;
#pragma unroll
        for (int q = 0; q < 4; ++q) { const int v0 = (4 * nh + q) * 16 + 4 * g4;
            const f32x4 gg = *(const f32x4*)(ng + v0); const u32x2 gw_ = *(const LAS u32x2*)(prow + v0);
            const float g0 = bflo(gw_.x), g1 = bfhi(gw_.x), g2 = bflo(gw_.y), g3 = bfhi(gw_.y);
            const float y0 = o[q][0] * rs * gg[0] * (g0 * sigmoidf_(g0)), y1 = o[q][1] * rs * gg[1] * (g1 * sigmoidf_(g1));
            const float y2 = o[q][2] * rs * gg[2] * (g2 * sigmoidf_(g2)), y3 = o[q][3] * rs * gg[3] * (g3 * sigmoidf_(g3));
            u32x2 wv; wv.x = pk2(y0, y1); wv.y = pk2(y2, y3);
            *(u32x2*)(YM + (size_t)(rowbase + t) * DM + 512 + h * 128 + v0) = wv; }
    }
    __syncthreads();
}
#ifndef MK_SPLIT
#define MK_SPLIT 0
#endif
constexpr int NPHASE = 12;
#ifndef PROBE_DUP
#define PROBE_DUP -1
#endif
#define REP(k) _Pragma("unroll") for (int rep_ = 0; rep_ < ((PROBE_DUP == (k)) ? 2 : 1); ++rep_)
#ifndef PROBE_DUP
#define PROBE_DUP -1
#endif
#ifndef REP
#define REP(k) _Pragma("unroll") for (int rep_ = 0; rep_ < ((PROBE_DUP == (k)) ? 2 : 1); ++rep_)
#endif
__device__ __forceinline__ int rw_unit_of(int G, int bid, int i) { return (G == 256) ? (((bid >> 4) << 7) + (bid & 15) + 16 * i) : (bid + i * G); }
__device__ __forceinline__ int gl_unit_of(int G, int bid, int i) { return (G == 256) ? (((bid >> 5) << 7) + (bid & 31) + 32 * i) : (bid + i * G); }
__device__ __forceinline__ void p2_body(const Frame& F, const Args& args) {
    REP(28) { const int nu = RW_UNITS / F.G; RwPref P;
      if (nu > 0) rw_prefetch(P, args, rw_unit_of(F.G, F.bid, 0), F.tid);
      for (int i = 0; i < nu; ++i) rwkv_chunk_unit(F, args, rw_unit_of(F.G, F.bid, i), P, (i + 1 < nu) ? rw_unit_of(F.G, F.bid, i + 1) : -1); }
    REP(29) { const int nu = GL_UNITS / F.G; GlPref<26> P;
      if (nu > 0) gl_prefetch<26>(P, args, gl_unit_of(F.G, F.bid, 0), F.tid);
      for (int i = 0; i < nu; ++i) gla_chunk_unit(F, args, gl_unit_of(F.G, F.bid, i), P, (i + 1 < nu) ? gl_unit_of(F.G, F.bid, i + 1) : -1); }
}
__device__ __forceinline__ void p4_gla(const Frame& F, const Args& args) {
    const int nu = GL_UNITS / F.G; GlPref<50> P;
    if (nu > 0) gl_prefetch<50>(P, args, gl_unit_of(F.G, F.bid, 0), F.tid);
    for (int i = 0; i < nu; ++i) gla_out_unit(F, args, gl_unit_of(F.G, F.bid, i), P, (i + 1 < nu) ? gl_unit_of(F.G, F.bid, i + 1) : -1);
}
__global__ void __launch_bounds__(NWAVES * 64, 2) mega_fwd(Args args) {
    extern __shared__ __attribute__((aligned(16))) unsigned char lds_raw[];
    Frame F;
    F.lds = (LAS unsigned char*)lds_raw;
    F.tid = threadIdx.x; F.lane = F.tid & 63; F.wave = __builtin_amdgcn_readfirstlane(F.tid >> 6);
    F.G = gridDim.x; F.bid = blockIdx.x;
    F.ctl = (unsigned*)(args.ws + WS_CTL);
    volatile LAS unsigned* MISC = (volatile LAS unsigned*)(F.lds + MISC_OFF);
    if (F.tid < 16) MISC[F.tid] = 0u;
    __syncthreads();
    const int lo = args.ph_lo, hi = args.ph_hi;
    XcdBarrier bar; bar.bar = F.ctl + CW_BAR; bar.x = 0; bar.st = MISC;
    if (hi - lo > 1) bar = xcd_barrier_post(F.ctl + CW_BAR, MISC);
#ifndef PH_MASK
#define PH_MASK 0xFFF
#endif
#define IN(k) ((((PH_MASK) >> (k)) & 1) && lo <= (k) && (k) < hi)
#define SEAM(k) do { if (IN(k) && IN((k) + 1)) xcd_barrier(bar); } while (0)
    unsigned char* ws = args.ws;

    if (IN(0)) REP(0) { p0_prologue(F, args); __syncthreads(); }
    SEAM(0);
    if (IN(1)) REP(1) {
        { pg8::Gemm g{(const bf16*)(ws + WS_U), (const bf16*)(ws + WS_WINT), NTOK, NPROJ, DM}; pg8::StaticOrder S; S.init(NTOK, NPROJ, F.G, F.bid);
          EpiBf16 E{(bf16*)(ws + WS_PROJ), NPROJ};
          pg8::gemm_phase<EpiBf16, pg8::StaticOrder, false, true, true>(F.lds, g, S, E); }
        { pg8::Gemm g{(const bf16*)(ws + WS_PB), (const bf16*)(ws + WS_WPT), NTOK, DM, 256}; pg8::StaticOrder S; S.init(NTOK, DM, F.G, F.bid);
          EpiBf16 E{(bf16*)(ws + WS_PP), DM};
          pg8::gemm_phase<EpiBf16, pg8::StaticOrder, false, true, true>(F.lds, g, S, E); }
    }
    SEAM(1);
    if (IN(2)) { p2_body(F, args); }
    SEAM(2);
    if (IN(3)) REP(3) {
        if (F.bid < 64) { rwkv_scan_wg(F, args, F.bid); }
        else { for (int idx = (F.bid - 64) * 512 + F.tid; idx < NB * 4 * 8192; idx += (F.G - 64) * 512) gla_scan_thread(args, idx); }
    }
    SEAM(3);
    if (IN(4)) REP(4) {
        for (int u = F.bid * NWAVES + F.wave; u < RW_UNITS; u += F.G * NWAVES) rwkv_out_wave(args, u, F.lane);
        p4_gla(F, args);
    }
    SEAM(4);
    if (IN(5)) REP(5) {
        pg8::Gemm g{(const bf16*)(ws + WS_YMIX), (const bf16*)(ws + WS_WOUTT), NTOK, DM, DM}; pg8::StaticOrder S; S.init(NTOK, DM, F.G, F.bid);
        EpiResF32 E{args.in[0], (float*)(ws + WS_H1)};
        pg8::gemm_phase<EpiResF32, pg8::StaticOrder, false, false, true>(F.lds, g, S, E);
    }
    SEAM(5);
    if (IN(6)) { if (PROBE_DUP == 6) { p6_router(F, args, F.ctl + CW_CNT + 64 * 64, 690 * MiB, 693 * MiB); __syncthreads(); }
        p6_router(F, args, F.ctl + CW_CNT, WS_RT, WS_GW); __syncthreads(); }
    SEAM(6);
    if (IN(7)) REP(7) {
        const int npan = moe_tables(F, args, 8, true);
        pg8::Gemm g{(const bf16*)(ws + WS_U), (const bf16*)(ws + WS_W1T), NTOK, 2048, DM};
        MoeOrder S{F.G, F.bid, 8, npan, (const LAS int*)(F.lds + MOE_TAB_OFF), (const LAS int*)(F.lds + MOE_ROWTAB_OFF)};
        EpiSwiglu E{(bf16*)(ws + WS_ACT), args.in[23]};
        pg8::gemm_phase<EpiSwiglu, MoeOrder, true, true, true>(F.lds, g, S, E);
    }
    SEAM(7);
    if (IN(8)) REP(8) {
        const int npan = moe_tables(F, args, 4, false);
        pg8::Gemm g{(const bf16*)(ws + WS_ACT), (const bf16*)(ws + WS_W2T), NTOK, DM, DFF};
        MoeOrder S{F.G, F.bid, 4, npan, (const LAS int*)(F.lds + MOE_TAB_OFF), (const LAS int*)(F.lds + MOE_ROWTAB_OFF)};
        EpiMoeOut E{(bf16*)(ws + WS_YB), args.in[25], (const int*)(ws + WS_RT), (const float*)(ws + WS_GW), F.ctl + CW_CNT};
        pg8::gemm_phase<EpiMoeOut, MoeOrder, false, true, true>(F.lds, g, S, E);
    }
    SEAM(8);
    if (IN(9)) { p9_combine(F, args); }
    SEAM(9);
    if (IN(10)) REP(10) {
        pg8::Gemm g{(const bf16*)(ws + WS_U), (const bf16*)(ws + WS_WGT), NTOK, DM, DM}; pg8::StaticOrder S; S.init(NTOK, DM, F.G, F.bid);
        EpiGate E{(const float*)(ws + WS_H1), (const bf16*)(ws + WS_PP), args.out};
        pg8::gemm_phase<EpiGate, pg8::StaticOrder, false, false, true>(F.lds, g, S, E);
    }
    SEAM(10);
    if (IN(11)) { p11_final(F, args); }
#undef IN
#undef SEAM
}

extern "C" void kernel_launch(void* const* d_in, const int* in_sizes, int n_in, void* d_out, int out_size, void* d_ws, size_t ws_size, hipStream_t stream) {
    static int grid = 0;
    if (grid == 0) {
        if (n_in != 30 || out_size != NTOK * DM || ws_size < WS_END) { fprintf(stderr, "kernel_launch: unexpected shapes (n_in %d, out %d, ws %zu)\n", n_in, out_size, ws_size); grid = -1; return; }
        int dev = 0, cus = 0, per_cu = 0;
        if (hipGetDevice(&dev) != hipSuccess || hipDeviceGetAttribute(&cus, hipDeviceAttributeMultiprocessorCount, dev) != hipSuccess) { grid = -1; return; }
        if (hipFuncSetAttribute((const void*)mega_fwd, hipFuncAttributeMaxDynamicSharedMemorySize, LDS_BYTES) != hipSuccess) { fprintf(stderr, "kernel_launch: hipFuncSetAttribute failed\n"); grid = -1; return; }
        if (hipOccupancyMaxActiveBlocksPerMultiprocessor(&per_cu, (const void*)mega_fwd, NWAVES * 64, LDS_BYTES) != hipSuccess || per_cu < 1) { fprintf(stderr, "kernel_launch: occupancy query says %d blocks per CU\n", per_cu); }
        (void)hipGetLastError();
        grid = cus;
    }
    if (grid < 0) return;
    if (hipMemsetAsync((char*)d_ws + WS_CTL, 0, CTL_ZERO_BYTES, stream) != hipSuccess) return;
    Args a{};
    for (int i = 0; i < 30; ++i) a.in[i] = (const float*)d_in[i];
    a.out = (float*)d_out; a.ws = (unsigned char*)d_ws; a.rp = (PROBE_DUP >= 100) ? PROBE_DUP - 100 : -1; a.pad = 0;
#if MK_SPLIT
    for (int p = 0; p < NPHASE; ++p) { a.ph_lo = p; a.ph_hi = p + 1; hipLaunchKernelGGL(mega_fwd, dim3(grid), dim3(NWAVES * 64), LDS_BYTES, stream, a); }
#else
    a.ph_lo = 0; a.ph_hi = NPHASE; hipLaunchKernelGGL(mega_fwd, dim3(grid), dim3(NWAVES * 64), LDS_BYTES, stream, a);
#endif
}
```
